# Optimizing an MI355X kernel written in HIP

```python
import math
import jax, jax.numpy as jnp
from jax import lax
import numpy as np

D_MODEL = 2048
BATCH = 1
SEQ = 8192
DEPTH = 1

MEM_LEN = 256
HEAD_DIM = 128
GLA_HEADS = 4
GLA_DK = 64
GLA_DV = 128
GLA_LOWRANK = 16
GLA_TAU = 16.0
GLA_CHUNK = 64
NSA_HEADS = 8
NSA_KV_HEADS = 2
NSA_DK = HEAD_DIM
CMP_LEN = 32
CMP_STRIDE = 16
CMP_HIDDEN = 256
SEL_LEN = 64
SEL_TOPK = 16
WINDOW = 512
MEM_HEADS = 4
MEM_DK = HEAD_DIM
D_MIX = GLA_HEADS * GLA_DV + NSA_HEADS * NSA_DK + MEM_HEADS * MEM_DK
D_FF = 5632
MACARON_W = 0.5
QBLK = 128
ROPE_THETA = 10000.0
EPS = 1e-6
NEG_INF = -1e30
TINY = 1e-30
FORCE_SCORE = 1e4

IN_SIZES = (GLA_HEADS * GLA_DK, GLA_HEADS * GLA_DK, GLA_HEADS * GLA_DV, GLA_HEADS * GLA_DV, GLA_LOWRANK,
            NSA_HEADS * NSA_DK) + (NSA_KV_HEADS * NSA_DK,) * 6 + (NSA_HEADS * 3, MEM_HEADS * MEM_DK)
D_IN = sum(IN_SIZES)

kernel_name = 'hybrid_gla_nsa_memx_macaron'


def rms_norm(x, g):
    xf = x.astype(jnp.float32)
    y = xf * lax.rsqrt(jnp.mean(xf * xf, axis=-1, keepdims=True) + EPS)
    return (y * g.astype(jnp.float32)).astype(x.dtype)


def rope(x, pos):
    half = x.shape[-1] // 2
    inv = ROPE_THETA ** (-jnp.arange(half, dtype=jnp.float32) / half)
    ang = pos.astype(jnp.float32)[:, None, :, None] * inv
    cos, sin = jnp.cos(ang), jnp.sin(ang)
    x1 = x[..., :half].astype(jnp.float32)
    x2 = x[..., half:].astype(jnp.float32)
    return jnp.concatenate([x1 * cos - x2 * sin, x2 * cos + x1 * sin], axis=-1).astype(x.dtype)


def heads(t, h):
    b, s, _ = t.shape
    return t.reshape(b, s, h, -1).transpose(0, 2, 1, 3)


def merge(t):
    b, h, s, d = t.shape
    return t.transpose(0, 2, 1, 3).reshape(b, s, h * d)


def masked_softmax(s, valid):
    s = jnp.where(valid, s, NEG_INF)
    e = jnp.exp(s - jnp.max(s, axis=-1, keepdims=True)) * valid
    return e / jnp.maximum(jnp.sum(e, axis=-1, keepdims=True), TINY)


def swiglu(x, w_gate, w_up, w_down):
    return (jax.nn.silu(x @ w_gate) * (x @ w_up)) @ w_down


def gla_chunked(q, k, v, log_a):
    b_, h_, s_, dk = q.shape
    dv = v.shape[-1]
    c = GLA_CHUNK
    n = s_ // c
    scale = dk ** -0.5
    causal = jnp.tril(jnp.ones((c, c), dtype=bool))

    def chunks(t):
        return jnp.moveaxis(t.reshape(b_, h_, n, c, t.shape[-1]), 2, 0)

    def step(state, inp):
        qc, kc, vc, lac = inp
        qc = qc.astype(jnp.float32) * scale
        kc = kc.astype(jnp.float32)
        vc = vc.astype(jnp.float32)
        bcum = jnp.cumsum(lac, axis=2)
        blast = bcum[:, :, -1:, :]
        o_inter = jnp.einsum('bhcd,bhde->bhce', qc * jnp.exp(bcum), state)
        decay = jnp.exp(jnp.where(causal[:, :, None], bcum[:, :, :, None, :] - bcum[:, :, None, :, :], -jnp.inf))
        attn = jnp.einsum('bhid,bhjd,bhijd->bhij', qc, kc, decay)
        o = o_inter + jnp.einsum('bhij,bhje->bhie', attn, vc)
        state = state * jnp.exp(blast)[:, :, 0, :, None] + jnp.einsum('bhcd,bhce->bhde', kc * jnp.exp(blast - bcum), vc)
        return state, o

    state0 = jnp.zeros((b_, h_, dk, dv), jnp.float32)
    _, o = lax.scan(step, state0, (chunks(q), chunks(k), chunks(v), chunks(log_a)))
    return jnp.moveaxis(o, 0, 2).reshape(b_, h_, s_, dv)


def nsa_attention(q, kc_raw, vc_raw, ks, vs, kw, vw, gates, positions, k_norm,
                  cmp_pos_k, cmp_w1_k, cmp_w2_k, cmp_pos_v, cmp_w1_v, cmp_w2_v):
    b_, hq, s_, dk = q.shape
    g_ = NSA_KV_HEADS
    hpg = hq // g_
    scale = dk ** -0.5

    n_cmp = (s_ - CMP_LEN) // CMP_STRIDE + 1
    cmp_start = jnp.arange(n_cmp) * CMP_STRIDE
    cmp_last = cmp_start + CMP_LEN - 1
    blk_idx = cmp_start[:, None] + jnp.arange(CMP_LEN)[None, :]

    def compress(t, pos_emb, w1, w2):
        blocks = t[:, :, blk_idx, :] + pos_emb
        flat = blocks.reshape(b_, g_, n_cmp, CMP_LEN * dk)
        return jax.nn.silu(flat @ w1) @ w2

    k_cmp = rope(rms_norm(compress(kc_raw, cmp_pos_k, cmp_w1_k, cmp_w2_k), k_norm[0]), positions[:, cmp_last])
    v_cmp = compress(vc_raw, cmp_pos_v, cmp_w1_v, cmp_w2_v)

    n_sel = s_ // SEL_LEN
    topk = min(SEL_TOPK, n_sel)
    sel_start = jnp.arange(n_sel) * SEL_LEN
    sel_ids = jnp.arange(n_sel)
    overlap = jnp.clip(jnp.minimum(cmp_start[:, None] + CMP_LEN, sel_start[None, :] + SEL_LEN)
                       - jnp.maximum(cmp_start[:, None], sel_start[None, :]), 0).astype(jnp.float32) / CMP_STRIDE

    kw_pad = jnp.pad(kw, ((0, 0), (0, 0), (WINDOW, 0), (0, 0)))
    vw_pad = jnp.pad(vw, ((0, 0), (0, 0), (WINDOW, 0), (0, 0)))
    bidx = jnp.arange(b_)[:, None, None, None]
    gidx = jnp.arange(g_)[None, :, None, None]
    qg = q.reshape(b_, g_, hpg, s_, dk)

    def block(qb):
        t0 = qb * QBLK
        tq = t0 + jnp.arange(QBLK)
        qs = lax.dynamic_slice_in_dim(qg, t0, QBLK, axis=3)
        gs = jax.nn.sigmoid(lax.dynamic_slice_in_dim(gates, t0, QBLK, axis=3).astype(jnp.float32))

        s = jnp.einsum('bghqd,bgnd->bghqn', qs, k_cmp).astype(jnp.float32) * scale
        p_cmp = masked_softmax(s, cmp_last[None, :] <= tq[:, None])
        o_cmp = jnp.einsum('bghqn,bgnd->bghqd', p_cmp, v_cmp)

        imp = jnp.einsum('bghqn,nm->bgqm', p_cmp, overlap)
        cur = tq // SEL_LEN
        causal = sel_start[None, :] <= tq[:, None]
        forced = (sel_ids[None, :] == 0) | (sel_ids[None, :] == cur[:, None]) | (sel_ids[None, :] == cur[:, None] - 1)
        score = jnp.where(causal, jnp.where(forced, FORCE_SCORE, imp), -FORCE_SCORE)
        _, sel = lax.top_k(score, topk)
        tok = (sel[..., None] * SEL_LEN + jnp.arange(SEL_LEN)).reshape(b_, g_, QBLK, topk * SEL_LEN)
        k_sel = ks[bidx, gidx, tok]
        v_sel = vs[bidx, gidx, tok]
        s = jnp.einsum('bghqd,bgqtd->bghqt', qs, k_sel).astype(jnp.float32) * scale
        p = masked_softmax(s, (tok <= tq[:, None])[:, :, None])
        o_slc = jnp.einsum('bghqt,bgqtd->bghqd', p, v_sel)

        k_win = lax.dynamic_slice_in_dim(kw_pad, t0, WINDOW + QBLK, axis=2)
        v_win = lax.dynamic_slice_in_dim(vw_pad, t0, WINDOW + QBLK, axis=2)
        kpos = t0 - WINDOW + jnp.arange(WINDOW + QBLK)
        valid = (kpos[None, :] <= tq[:, None]) & (kpos[None, :] > tq[:, None] - WINDOW) & (kpos[None, :] >= 0)
        s = jnp.einsum('bghqd,bgkd->bghqk', qs, k_win).astype(jnp.float32) * scale
        p = masked_softmax(s, valid)
        o_win = jnp.einsum('bghqk,bgkd->bghqd', p, v_win)

        return gs[..., 0:1] * o_cmp + gs[..., 1:2] * o_slc + gs[..., 2:3] * o_win

    out = lax.map(block, jnp.arange(s_ // QBLK))
    return out.transpose(1, 0, 4, 2, 3, 5).reshape(b_, s_, hq * dk)


def memory_cross_attention(q, mem, mem_in_norm, w_mem_kv, mem_q_norm, mem_k_norm):
    qh = rms_norm(heads(q, MEM_HEADS), mem_q_norm)
    kv = rms_norm(mem, mem_in_norm) @ w_mem_kv
    k, v = jnp.split(kv, 2, axis=-1)
    kh = rms_norm(heads(k, MEM_HEADS), mem_k_norm)
    vh = heads(v, MEM_HEADS)
    s = jnp.einsum('bhsd,bhmd->bhsm', qh, kh).astype(jnp.float32) * (MEM_DK ** -0.5)
    p = jax.nn.softmax(s, axis=-1)
    return merge(jnp.einsum('bhsm,bhmd->bhsd', p, vh))


def hybrid_layer(x, mem, positions, ffn1_norm, ffn1_w_gate, ffn1_w_up, ffn1_w_down, mix_norm, w_in,
                 gla_w_a, gla_b_a, gla_o_norm, nsa_q_norm, nsa_k_norm, nsa_cmp_pos_k, nsa_cmp_w1_k,
                 nsa_cmp_w2_k, nsa_cmp_pos_v, nsa_cmp_w1_v, nsa_cmp_w2_v, mem_in_norm, w_mem_kv,
                 mem_q_norm, mem_k_norm, w_out, ffn2_norm, ffn2_w_gate, ffn2_w_up, ffn2_w_down, final_norm):
    dt = x.dtype
    x = x + MACARON_W * swiglu(rms_norm(x, ffn1_norm), ffn1_w_gate, ffn1_w_up, ffn1_w_down)

    h = rms_norm(x, mix_norm)
    proj = h @ w_in
    splits = [int(v) for v in np.cumsum(IN_SIZES)[:-1]]
    (g_q, g_k, g_v, g_r, g_a, n_q, n_kc, n_vc, n_ks, n_vs, n_kw, n_vw, n_g, m_q) = jnp.split(proj, splits, axis=-1)
    b_, s_, _ = x.shape

    log_a = jax.nn.log_sigmoid((g_a @ gla_w_a + gla_b_a).astype(jnp.float32)) / GLA_TAU
    o = gla_chunked(heads(g_q, GLA_HEADS), heads(g_k, GLA_HEADS), heads(g_v, GLA_HEADS), heads(log_a, GLA_HEADS))
    o_gla = (merge(rms_norm(o, gla_o_norm)) * jax.nn.silu(g_r.astype(jnp.float32))).astype(dt)

    q = rope(rms_norm(heads(n_q, NSA_HEADS), nsa_q_norm), positions)
    ks = rope(rms_norm(heads(n_ks, NSA_KV_HEADS), nsa_k_norm[1]), positions)
    kw = rope(rms_norm(heads(n_kw, NSA_KV_HEADS), nsa_k_norm[2]), positions)
    gates = n_g.reshape(b_, s_, NSA_KV_HEADS, NSA_HEADS // NSA_KV_HEADS, 3).transpose(0, 2, 3, 1, 4)
    o_nsa = nsa_attention(q, heads(n_kc, NSA_KV_HEADS), heads(n_vc, NSA_KV_HEADS), ks, heads(n_vs, NSA_KV_HEADS),
                          kw, heads(n_vw, NSA_KV_HEADS), gates, positions, nsa_k_norm,
                          nsa_cmp_pos_k, nsa_cmp_w1_k, nsa_cmp_w2_k, nsa_cmp_pos_v, nsa_cmp_w1_v, nsa_cmp_w2_v).astype(dt)

    o_mem = memory_cross_attention(m_q, mem, mem_in_norm, w_mem_kv, mem_q_norm, mem_k_norm).astype(dt)

    x = x + jnp.concatenate([o_gla, o_nsa, o_mem], axis=-1) @ w_out

    x = x + MACARON_W * swiglu(rms_norm(x, ffn2_norm), ffn2_w_gate, ffn2_w_up, ffn2_w_down)
    return rms_norm(x, final_norm)


def setup_inputs(seed: int = 0) -> dict:
    key = jax.random.key(seed)
    k = jax.random.split(key, 40)
    f32 = jnp.float32

    def w(kk, shape, fan_in):
        return jax.random.normal(kk, (DEPTH,) + shape, f32) * (fan_in ** -0.5)

    def gain(kk, shape):
        return 1.0 + 0.02 * jax.random.normal(kk, (DEPTH,) + shape, f32)

    def small(kk, shape, s):
        return s * jax.random.normal(kk, (DEPTH,) + shape, f32)

    return {
        'x': jax.random.normal(k[0], (BATCH, SEQ, D_MODEL), f32),
        'mem': jax.random.normal(k[1], (BATCH, MEM_LEN, D_MODEL), f32),
        'positions': jnp.broadcast_to(jnp.arange(SEQ, dtype=jnp.int32), (BATCH, SEQ)),
        'ffn1_norm': gain(k[2], (D_MODEL,)),
        'ffn1_w_gate': w(k[3], (D_MODEL, D_FF), D_MODEL),
        'ffn1_w_up': w(k[4], (D_MODEL, D_FF), D_MODEL),
        'ffn1_w_down': w(k[5], (D_FF, D_MODEL), D_FF),
        'mix_norm': gain(k[6], (D_MODEL,)),
        'w_in': w(k[7], (D_MODEL, D_IN), D_MODEL),
        'gla_w_a': w(k[8], (GLA_LOWRANK, GLA_HEADS * GLA_DK), GLA_LOWRANK),
        'gla_b_a': small(k[9], (GLA_HEADS * GLA_DK,), 0.1),
        'gla_o_norm': gain(k[10], (GLA_DV,)),
        'nsa_q_norm': gain(k[11], (NSA_DK,)),
        'nsa_k_norm': gain(k[12], (3, NSA_DK)),
        'nsa_cmp_pos_k': small(k[13], (CMP_LEN, NSA_DK), 0.1),
        'nsa_cmp_w1_k': w(k[14], (CMP_LEN * NSA_DK, CMP_HIDDEN), CMP_LEN * NSA_DK),
        'nsa_cmp_w2_k': w(k[15], (CMP_HIDDEN, NSA_DK), CMP_HIDDEN),
        'nsa_cmp_pos_v': small(k[16], (CMP_LEN, NSA_DK), 0.1),
        'nsa_cmp_w1_v': w(k[17], (CMP_LEN * NSA_DK, CMP_HIDDEN), CMP_LEN * NSA_DK),
        'nsa_cmp_w2_v': w(k[18], (CMP_HIDDEN, NSA_DK), CMP_HIDDEN),
        'mem_in_norm': gain(k[19], (D_MODEL,)),
        'w_mem_kv': w(k[20], (D_MODEL, 2 * MEM_HEADS * MEM_DK), D_MODEL),
        'mem_q_norm': gain(k[21], (MEM_DK,)),
        'mem_k_norm': gain(k[22], (MEM_DK,)),
        'w_out': w(k[23], (D_MIX, D_MODEL), D_MIX),
        'ffn2_norm': gain(k[24], (D_MODEL,)),
        'ffn2_w_gate': w(k[25], (D_MODEL, D_FF), D_MODEL),
        'ffn2_w_up': w(k[26], (D_MODEL, D_FF), D_MODEL),
        'ffn2_w_down': w(k[27], (D_FF, D_MODEL), D_FF),
        'final_norm': gain(k[28], (D_MODEL,)),
    }


def reference(x, mem, positions, ffn1_norm, ffn1_w_gate, ffn1_w_up, ffn1_w_down, mix_norm, w_in,
              gla_w_a, gla_b_a, gla_o_norm, nsa_q_norm, nsa_k_norm, nsa_cmp_pos_k, nsa_cmp_w1_k,
              nsa_cmp_w2_k, nsa_cmp_pos_v, nsa_cmp_w1_v, nsa_cmp_w2_v, mem_in_norm, w_mem_kv,
              mem_q_norm, mem_k_norm, w_out, ffn2_norm, ffn2_w_gate, ffn2_w_up, ffn2_w_down, final_norm):
    for l in range(DEPTH):
        x = hybrid_layer(x, mem, positions, ffn1_norm[l], ffn1_w_gate[l], ffn1_w_up[l], ffn1_w_down[l],
                         mix_norm[l], w_in[l], gla_w_a[l], gla_b_a[l], gla_o_norm[l], nsa_q_norm[l],
                         nsa_k_norm[l], nsa_cmp_pos_k[l], nsa_cmp_w1_k[l], nsa_cmp_w2_k[l], nsa_cmp_pos_v[l],
                         nsa_cmp_w1_v[l], nsa_cmp_w2_v[l], mem_in_norm[l], w_mem_kv[l], mem_q_norm[l],
                         mem_k_norm[l], w_out[l], ffn2_norm[l], ffn2_w_gate[l], ffn2_w_up[l], ffn2_w_down[l],
                         final_norm[l])
    return x
```

```cpp
#include <hip/hip_runtime.h>
#include <hip/hip_cooperative_groups.h>
#include <cstdio>
namespace cg = cooperative_groups;

#ifndef NPH
#define NPH 4
#endif

#ifndef DUP
#define DUP 0
#endif
#ifndef DUPSUB
#define DUPSUB 7
#endif
#define REPS(k) for (int rep_ = 0; rep_ < (((DUP) >> (k)) & 1) + 1; ++rep_)

#define LAS __attribute__((address_space(3)))
#define GAS __attribute__((address_space(1)))
typedef unsigned short bf16_t;
typedef short bf16x8 __attribute__((ext_vector_type(8)));
typedef float f32x4 __attribute__((ext_vector_type(4)));
typedef unsigned u32x4 __attribute__((ext_vector_type(4)));
typedef unsigned u32x2 __attribute__((ext_vector_type(2)));
typedef unsigned long long u64;

constexpr int S_ = 8192, D_ = 2048, FF_ = 5632, NPJ = 4864, MEMLEN = 256;
constexpr int LD2 = 2048 + 64, LDF = 5632 + 64;
constexpr float EPS_ = 1e-6f;
constexpr int PC_GQ = 0, PC_GK = 256, PC_GV = 512, PC_GR = 1024, PC_NQ = 1536, PC_KC = 2560, PC_VC = 2816, PC_KS = 3072, PC_VS = 3328,
              PC_KW = 3584, PC_VW = 3840, PC_MQ = 4096, PC_GA = 4608, PC_NG = 4624;

constexpr size_t AL(size_t x) { return (x + 255) & ~(size_t)255; }
constexpr size_t OFF_WFF = 0;
constexpr size_t OFF_WD = OFF_WFF + (size_t)11264 * LD2 * 2;
constexpr size_t OFF_WIN = OFF_WD + (size_t)2048 * LDF * 2;
constexpr size_t OFF_WOUT = OFF_WIN + (size_t)NPJ * LD2 * 2;
constexpr size_t OFF_WMEM = OFF_WOUT + (size_t)2048 * LD2 * 2;
constexpr size_t OFF_WC1 = OFF_WMEM + (size_t)1024 * LD2 * 2;
constexpr size_t OFF_ACT = OFF_WC1 + (size_t)2 * 256 * 4096 * 2;
constexpr size_t OFF_XB = OFF_ACT + (size_t)S_ * LDF * 2;
constexpr size_t OFF_MIX = OFF_XB + (size_t)S_ * LD2 * 2;
constexpr size_t OFF_X2 = OFF_MIX + (size_t)S_ * LD2 * 2;
constexpr size_t OFF_QN = OFF_X2;
constexpr size_t OFF_KSN = OFF_QN + (size_t)8 * S_ * 128 * 2;
constexpr size_t OFF_KWN = OFF_KSN + (size_t)2 * S_ * 128 * 2;
constexpr size_t OFF_VST = OFF_KWN + (size_t)2 * S_ * 128 * 2;
constexpr size_t OFF_VWT = OFF_VST + (size_t)2 * S_ * 128 * 2;
constexpr size_t OFF_KCB = OFF_VWT + (size_t)2 * S_ * 128 * 2;
constexpr size_t OFF_VCB = OFF_KCB + (size_t)2 * S_ * 128 * 2 + 65536;
constexpr size_t OFF_MQN = OFF_VCB + (size_t)2 * S_ * 128 * 2 + 65536;
constexpr size_t OFF_LA = OFF_MQN + (size_t)4 * S_ * 128 * 2;
constexpr size_t OFF_GATE = OFF_LA + (size_t)S_ * 256 * 4;
constexpr size_t OFF_X2END = OFF_GATE + (size_t)S_ * 24 * 4;
static_assert(OFF_X2END <= OFF_X2 + (size_t)S_ * D_ * 4, "attention-stage buffers overflow the x2 region");
constexpr size_t OFF_ONSA = OFF_X2 + (size_t)S_ * D_ * 4;
constexpr size_t OFF_GLAS = OFF_ONSA + (size_t)S_ * 1024 * 4;
constexpr size_t OFF_ROPE = OFF_GLAS + (size_t)4 * 128 * 64 * 128 * 4;
constexpr size_t OFF_SSQ = OFF_ROPE + (size_t)2 * S_ * 64 * 4;
constexpr size_t OFF_SSQM = OFF_SSQ + (size_t)4 * S_ * 8;
constexpr size_t OFF_MEMB = OFF_SSQM + 256 * 8;
constexpr size_t OFF_KVMEM = OFF_MEMB + (size_t)256 * LD2 * 2;
constexpr size_t OFF_MEMK = OFF_KVMEM + (size_t)256 * 1024 * 4;
constexpr size_t OFF_MEMVT = OFF_MEMK + (size_t)4 * 256 * 128 * 2;
constexpr size_t OFF_HID = OFF_MEMVT + (size_t)4 * 256 * 128 * 2;
constexpr size_t OFF_C2 = OFF_HID + (size_t)4 * 512 * 256 * 4;
constexpr size_t OFF_KCMP = OFF_C2 + (size_t)4 * 512 * 128 * 4;
constexpr size_t OFF_VCMPT = OFF_KCMP + (size_t)2 * 512 * 128 * 2;
constexpr size_t OFF_SEL = OFF_VCMPT + (size_t)2 * 512 * 128 * 2;
constexpr size_t OFF_DEC = OFF_SEL + (size_t)2 * S_ * 4 * 4;
constexpr size_t OFF_CBIAS = OFF_DEC + (size_t)4 * 128 * 64 * 4;
constexpr size_t OFF_BAR = OFF_CBIAS + 2 * 256 * 128 + 4096;
constexpr size_t BAR_BYTES = 3456 * 4;
constexpr size_t OFF_PCNT = OFF_BAR + BAR_BYTES + 4096;
constexpr size_t WS_END = OFF_PCNT + 64 * 256 + 4096;

constexpr int LDS_MAIN = 147456;
constexpr int LDS_BYTES = LDS_MAIN + 64;
extern __shared__ __attribute__((aligned(16))) unsigned char smem_raw[];

struct Params {
    const float* x; const float* mem; const int* pos;
    const float* ffn1_norm; const float* ffn1_wg; const float* ffn1_wu; const float* ffn1_wd;
    const float* mix_norm; const float* w_in; const float* gla_wa; const float* gla_ba; const float* gla_onorm;
    const float* q_norm; const float* k_norm; const float* cmp_pos_k; const float* cmp_w1_k; const float* cmp_w2_k;
    const float* cmp_pos_v; const float* cmp_w1_v; const float* cmp_w2_v; const float* mem_in_norm; const float* w_mem_kv;
    const float* mem_q_norm; const float* mem_k_norm; const float* w_out; const float* ffn2_norm; const float* ffn2_wg;
    const float* ffn2_wu; const float* ffn2_wd; const float* final_norm;
    float* out; unsigned char* ws;
};

__device__ __forceinline__ unsigned cvt_pk_bf16(float lo, float hi) { unsigned r; asm("v_cvt_pk_bf16_f32 %0, %1, %2" : "=v"(r) : "v"(lo), "v"(hi)); return r; }
__device__ __forceinline__ float bf2f(bf16_t b) { return __uint_as_float(((unsigned)b) << 16); }
__device__ __forceinline__ bf16_t f2bf(float f) { unsigned u = __float_as_uint(f); u += 0x7FFFu + ((u >> 16) & 1u); return (bf16_t)(u >> 16); }
__device__ __forceinline__ float wave_sum(float v) {
#pragma unroll
    for (int o = 32; o >= 1; o >>= 1) v += __shfl_xor(v, o);
    return v;
}
__device__ __forceinline__ float sigmoid_f(float x) { return __builtin_amdgcn_rcpf(1.0f + __builtin_amdgcn_exp2f(-1.4426950408889634f * x)); }
__device__ __forceinline__ float silu_f(float x) { return x * sigmoid_f(x); }
__device__ __forceinline__ u64 ssq_fix(float s) { return (u64)(s * 16777216.0f + 0.5f); }
__device__ __forceinline__ float rstd_from(const u64* ssq, int row) { const float s = (float)((const GAS u64*)ssq)[row] * (1.0f / 16777216.0f); return rsqrtf(s * (1.0f / 2048.0f) + EPS_); }


#define XB_TMO      128
#define XB_XCNT(j)  (256  + 64 * (j))
#define XB_XSUB(j)  (1280 + 64 * (j))
#define XB_XGEN(j)  (2304 + 64 * (j))
#define XB_TOP      3328
#define XB_TOPGEN   3392
#define XCD_BAR_WORDS 3456
#define XB_SPIN_CAP (1u << 18)
__device__ __forceinline__ unsigned xb_ld(unsigned* p)              { return __hip_atomic_load(p, __ATOMIC_RELAXED, __HIP_MEMORY_SCOPE_AGENT); }
__device__ __forceinline__ unsigned xb_add(unsigned* p, unsigned v) { return __hip_atomic_fetch_add(p, v, __ATOMIC_RELAXED, __HIP_MEMORY_SCOPE_AGENT); }
__device__ __forceinline__ unsigned xb_xcc_id() { return (unsigned)__builtin_amdgcn_s_getreg((3 << 11) | 20) & 0xFu; }
#define XB_SPIN(cond, bar) do { unsigned _sp = 0; while (cond) { __builtin_amdgcn_s_sleep(1); \
    if ((++_sp & 255u) == 0u) { if (xb_ld(&(bar)[XB_TMO])) break; if (_sp > XB_SPIN_CAP) { atomicAdd(&(bar)[XB_TMO], 1u); break; } } } } while (0)
struct XcdBarrier { unsigned* bar; unsigned x; volatile LAS unsigned* st; };
__device__ __forceinline__ XcdBarrier xcd_barrier_post(unsigned* bar, volatile LAS unsigned* st) {
    XcdBarrier b; b.bar = bar; b.x = xb_xcc_id(); b.st = st;
    if (threadIdx.x == 0) st[2] = xb_add(&bar[XB_XCNT(b.x)], 1u);
    return b;
}
__device__ __forceinline__ void xcd_barrier_complete(unsigned* bar, unsigned x, unsigned& nloc, unsigned& nx) {
    const unsigned G = gridDim.x * gridDim.y * gridDim.z;
    unsigned sum, cnt, mine, sp = 0u;
    for (;;) {
        sum = 0u; cnt = 0u; mine = 0u;
#pragma unroll
        for (unsigned j = 0; j < 16; ++j) { const unsigned c = xb_ld(&bar[XB_XCNT(j)]); sum += c; cnt += (c > 0u) ? 1u : 0u; mine = (j == x) ? c : mine; }
        if (sum == G) break;
        __builtin_amdgcn_s_sleep(1);
        if ((++sp & 255u) == 0u) { if (xb_ld(&bar[XB_TMO])) break; if (sp > XB_SPIN_CAP) { atomicAdd(&bar[XB_TMO], 1u); break; } }
    }
    nloc = mine > 0u ? mine : 1u; nx = cnt > 0u ? cnt : 1u;
}
__device__ __forceinline__ void xcd_barrier(const XcdBarrier& b) {
    asm volatile("s_waitcnt vmcnt(0)" ::: "memory");
    __syncthreads();
    if (threadIdx.x == 0) {
        unsigned* bar = b.bar;
        __builtin_amdgcn_s_waitcnt(0);
        unsigned nloc = b.st[0], nx = b.st[1];
        if (nloc == 0u) { xcd_barrier_complete(bar, b.x, nloc, nx); b.st[0] = nloc; b.st[1] = nx; }
        const unsigned old = xb_add(&bar[XB_XSUB(b.x)], 1u);
        const unsigned gen = old / nloc;
        if (old + 1u == (gen + 1u) * nloc) {
            __builtin_amdgcn_fence(__ATOMIC_RELEASE, "agent");
            asm volatile("s_waitcnt vmcnt(0)" ::: "memory");
            const unsigned og = xb_add(&bar[XB_TOP], 1u);
            const unsigned tg = og / nx;
            if (og + 1u == (tg + 1u) * nx) xb_add(&bar[XB_TOPGEN], 1u);
            else XB_SPIN(xb_ld(&bar[XB_TOPGEN]) == tg, bar);
            __builtin_amdgcn_fence(__ATOMIC_ACQUIRE, "agent");
            xb_add(&bar[XB_XGEN(b.x)], 1u);
            asm volatile("s_waitcnt vmcnt(0)" ::: "memory");
        } else {
            XB_SPIN(xb_ld(&bar[XB_XGEN(b.x)]) == gen, bar);
            __builtin_amdgcn_fence(__ATOMIC_ACQUIRE, "agent");
            asm volatile("s_waitcnt vmcnt(0)" ::: "memory");
        }
    }
    __syncthreads();
}

namespace pg8 {
constexpr int BM = 256, BK = 64, HALF = 128, HTB = HALF * BK * 2, STAGE_BYTES = 8 * HTB, NXCD = 8, WGM = 8;
__device__ __forceinline__ int lds_byte(int r, int c) { const int st = (r >> 4) * 2 + (c >> 5), rr = r & 15, cc = c & 31, ob = rr * 64 + cc * 2; return st * 1024 + (ob ^ (((ob >> 9) & 1) << 5)); }
__device__ __forceinline__ void stage_rc(int b, int& R, int& C) { const int st = b / 1024, sb = b % 1024, swz = sb ^ (((sb >> 9) & 1) << 5); R = (st >> 1) * 16 + swz / 64; C = (st & 1) * 32 + (swz % 64) / 2; }
__device__ __forceinline__ int perm32(int rho) { const int n = rho >> 4, i = rho & 15; return 8 * (i >> 2) + 4 * n + (i & 3); }
struct Unit { int pm, pn; };
struct Gemm { const bf16_t* A; const bf16_t* Bt; int M, N, K, lda, ldb; };
struct StaticOrder {
    int nM, nN, nwg, G, c;
    __device__ void init(int M, int N, int G_, int c_) { nM = M / BM; nN = N / BM; nwg = nM * nN; G = G_; c = c_; }
    __device__ bool next(int i, Unit& u) const {
        const long L = (long)i * G + c; if (L >= nwg) return false;
        int wgid = (int)L; { const int q = nwg / NXCD, r = nwg % NXCD, xcd = wgid % NXCD, off = wgid / NXCD; wgid = (xcd < r ? xcd * (q + 1) : r * (q + 1) + (xcd - r) * q) + off; }
        const int nig = WGM * nN, gid = wgid / nig, fm = gid * WGM, gsz = (nM - fm) < WGM ? (nM - fm) : WGM;
        u.pm = fm + ((wgid % nig) % gsz); u.pn = (wgid % nig) / gsz; return true;
    }
};

template <class Epi, class Sched>
__device__ __forceinline__ void gemm_phase(LAS unsigned char* lds, const Gemm g, const Sched& S, const Epi& E) {
    int tid = threadIdx.x; asm volatile("" : "+v"(tid));
    const int wid = __builtin_amdgcn_readfirstlane(tid >> 6), lane = tid & 63, wr = wid >> 2, wc = wid & 3, fr = lane & 15, fq = lane >> 4;
    const int K = g.K, nt = K / BK;
    unsigned voffA[2], voffB[2];
#pragma unroll
    for (int i = 0; i < 2; ++i) { int R, C; stage_rc(tid * 16 + i * 8192, R, C); const int Rb = Epi::PERM ? ((R & ~31) + perm32(R & 31)) : R;
        voffA[i] = (unsigned)(R * g.lda + C) * 2u; voffB[i] = (unsigned)(Rb * g.ldb + C) * 2u; }
    const size_t kstep = (size_t)(BK * 2);
    const size_t hstepA = (size_t)HALF * g.lda * 2, hstepB = (size_t)HALF * g.ldb * 2;
    const size_t tstepA = 2 * hstepA, tstepB = 2 * hstepB;
    const unsigned ldsw = (unsigned)wid * 1024u;
    const int aoff = lds_byte(wr * 64 + fr, fq * 8), boff = lds_byte(wc * 32 + fr, fq * 8);
#define PG8_SA(b, h) (((b) * 2 + (h)) * HTB)
#define PG8_SB(b, h) ((4 + (b) * 2 + (h)) * HTB)
#define PG8_STAGE(bufoff, gbase, voff) do { _Pragma("unroll") for (int _i = 0; _i < 2; ++_i) \
        __builtin_amdgcn_global_load_lds((const unsigned*)((const char*)(gbase) + (voff)[_i]), (LAS unsigned*)(lds + (bufoff) + ldsw + _i * 8192), 16, 0, 0); } while (0)
#define PG8_LDA(dst, b, h) do { _Pragma("unroll") for (int m = 0; m < 4; ++m) _Pragma("unroll") for (int k = 0; k < 2; ++k) dst[m][k] = *(const LAS bf16x8*)(lds + PG8_SA(b, h) + aoff + m * 2048 + k * 1024); } while (0)
#define PG8_LDB(dst, b, h) do { _Pragma("unroll") for (int n = 0; n < 2; ++n) _Pragma("unroll") for (int k = 0; k < 2; ++k) dst[n][k] = *(const LAS bf16x8*)(lds + PG8_SB(b, h) + boff + n * 2048 + k * 1024); } while (0)
#define PG8_MMA(ai, bj, At, Bt) do { __builtin_amdgcn_s_setprio(1); _Pragma("unroll") for (int m = 0; m < 4; ++m) _Pragma("unroll") for (int n = 0; n < 2; ++n) _Pragma("unroll") for (int k = 0; k < 2; ++k) \
        acc[ai][bj][m][n] = __builtin_amdgcn_mfma_f32_16x16x32_bf16(Bt[n][k], At[m][k], acc[ai][bj][m][n], 0, 0, 0); __builtin_amdgcn_s_setprio(0); } while (0)
#define PG8_WAIT_V(n) asm volatile("s_waitcnt vmcnt(" #n ")" ::: "memory")
#define PG8_WAIT_L(n) asm volatile("s_waitcnt lgkmcnt(" #n ")" ::: "memory")
#define PG8_BAR __builtin_amdgcn_s_barrier()
#define PG8_SCHED __builtin_amdgcn_sched_barrier(0)
    Unit cur, nxt; int ui = 0;
    if (!S.next(0, cur)) return;
    f32x4 acc[2][2][4][2];
#pragma unroll
    for (int a = 0; a < 2; ++a)
#pragma unroll
        for (int b = 0; b < 2; ++b)
#pragma unroll
            for (int m = 0; m < 4; ++m)
#pragma unroll
                for (int n = 0; n < 2; ++n) acc[a][b][m][n] = (f32x4){0.f, 0.f, 0.f, 0.f};
    bf16x8 At[4][2], B0[2][2], B1[2][2];
    const char* cA = (const char*)g.A + (size_t)cur.pm * tstepA; const char* cB = (const char*)g.Bt + (size_t)cur.pn * tstepB;
    PG8_STAGE(PG8_SB(0, 0), cB, voffB); PG8_STAGE(PG8_SA(0, 0), cA, voffA); PG8_STAGE(PG8_SB(0, 1), cB + hstepB, voffB); PG8_STAGE(PG8_SA(0, 1), cA + hstepA, voffA);
    if (wr == 1) PG8_BAR;
    PG8_WAIT_V(4); PG8_BAR;
    PG8_STAGE(PG8_SB(1, 0), cB + kstep, voffB); PG8_STAGE(PG8_SA(1, 0), cA + kstep, voffA); PG8_STAGE(PG8_SB(1, 1), cB + hstepB + kstep, voffB);
    PG8_WAIT_V(6); PG8_BAR;
    for (;;) {
        const bool has_next = S.next(ui + 1, nxt);
        const char* nA = has_next ? (const char*)g.A + (size_t)nxt.pm * tstepA : cA; const char* nB = has_next ? (const char*)g.Bt + (size_t)nxt.pn * tstepB : cB;
        for (int t = 0; t < nt; t += 2) {
            const bool last = (t == nt - 2);
            const char* a1 = cA + (size_t)(t + 1) * kstep;
            const char* a2 = last ? nA : cA + (size_t)(t + 2) * kstep; const char* b2 = last ? nB : cB + (size_t)(t + 2) * kstep;
            const char* a3 = a2 + kstep; const char* b3 = b2 + kstep;
            PG8_LDB(B0, 0, 0); PG8_SCHED; PG8_LDA(At, 0, 0); PG8_STAGE(PG8_SA(1, 1), a1 + hstepA, voffA);
            PG8_WAIT_L(8); PG8_BAR; PG8_WAIT_L(0); PG8_MMA(0, 0, At, B0); PG8_BAR; PG8_SCHED;
            PG8_LDB(B1, 0, 1); PG8_STAGE(PG8_SB(0, 0), b2, voffB);
            PG8_BAR; PG8_WAIT_L(0); PG8_MMA(0, 1, At, B1); PG8_BAR;
            PG8_LDA(At, 0, 1); PG8_STAGE(PG8_SA(0, 0), a2, voffA);
            PG8_BAR; PG8_WAIT_L(0); PG8_MMA(1, 0, At, B0); PG8_BAR; PG8_SCHED;
            PG8_STAGE(PG8_SB(0, 1), b2 + hstepB, voffB);
            PG8_WAIT_V(6); PG8_BAR; PG8_MMA(1, 1, At, B1); PG8_BAR;
            PG8_LDB(B0, 1, 0); PG8_SCHED; PG8_LDA(At, 1, 0); PG8_STAGE(PG8_SA(0, 1), a2 + hstepA, voffA);
            PG8_WAIT_L(8); PG8_BAR; PG8_WAIT_L(0); PG8_MMA(0, 0, At, B0); PG8_BAR; PG8_SCHED;
            PG8_LDB(B1, 1, 1); PG8_STAGE(PG8_SB(1, 0), b3, voffB);
            PG8_BAR; PG8_WAIT_L(0); PG8_MMA(0, 1, At, B1); PG8_BAR;
            PG8_LDA(At, 1, 1); PG8_STAGE(PG8_SA(1, 0), a3, voffA);
            PG8_BAR; PG8_WAIT_L(0); PG8_MMA(1, 0, At, B0); PG8_BAR; PG8_SCHED;
            PG8_STAGE(PG8_SB(1, 1), b3 + hstepB, voffB);
            PG8_WAIT_V(6); PG8_BAR; PG8_MMA(1, 1, At, B1); PG8_BAR;
        }
        E(acc, cur, wr, wc, fr, fq);
        if (!has_next) break;
#pragma unroll
        for (int a = 0; a < 2; ++a)
#pragma unroll
            for (int b = 0; b < 2; ++b)
#pragma unroll
                for (int m = 0; m < 4; ++m)
#pragma unroll
                    for (int n = 0; n < 2; ++n) acc[a][b][m][n] = (f32x4){0.f, 0.f, 0.f, 0.f};
        cur = nxt; cA = nA; cB = nB; ++ui;
    }
    PG8_WAIT_V(0);
    if (wr == 0) PG8_BAR;
    PG8_BAR;
#undef PG8_SA
#undef PG8_SB
#undef PG8_STAGE
#undef PG8_LDA
#undef PG8_LDB
#undef PG8_MMA
#undef PG8_WAIT_V
#undef PG8_WAIT_L
#undef PG8_BAR
#undef PG8_SCHED
}
}
using pg8::Unit; using pg8::HALF; using pg8::BM;

struct EpiGateUp {
    static constexpr bool PERM = true;
    bf16_t* act; const u64* ssq;
    __device__ __forceinline__ void operator()(const f32x4 (&acc)[2][2][4][2], const Unit& u, int wr, int wc, int fr, int fq) const {
        const int row0 = u.pm * BM + wr * 64 + fr, col0 = u.pn * 128 + wc * 32 + 8 * fq;
        float rsv[2][4];
#pragma unroll
        for (int ai = 0; ai < 2; ++ai)
#pragma unroll
            for (int m = 0; m < 4; ++m) rsv[ai][m] = rstd_from(ssq, row0 + ai * HALF + m * 16);
#pragma unroll
        for (int ai = 0; ai < 2; ++ai)
#pragma unroll
            for (int m = 0; m < 4; ++m) {
                const int r = row0 + ai * HALF + m * 16; const float rs = rsv[ai][m];
                float o[8];
#pragma unroll
                for (int n = 0; n < 2; ++n)
#pragma unroll
                    for (int j = 0; j < 4; ++j) { const float gv = acc[ai][0][m][n][j] * rs, uv = acc[ai][1][m][n][j] * rs; o[n * 4 + j] = silu_f(gv) * uv; }
                u32x4 pk = {cvt_pk_bf16(o[0], o[1]), cvt_pk_bf16(o[2], o[3]), cvt_pk_bf16(o[4], o[5]), cvt_pk_bf16(o[6], o[7])};
                *(GAS u32x4*)((GAS bf16_t*)act + (size_t)r * LDF + col0) = pk;
            }
    }
};
struct EpiScaleBf16 {
    static constexpr bool PERM = true;
    bf16_t* O; int ldc; const u64* ssq;
    __device__ __forceinline__ void operator()(const f32x4 (&acc)[2][2][4][2], const Unit& u, int wr, int wc, int fr, int fq) const {
        const int row0 = u.pm * BM + wr * 64 + fr, col0 = u.pn * BM + wc * 32 + 8 * fq;
        float rsv[2][4];
#pragma unroll
        for (int ai = 0; ai < 2; ++ai)
#pragma unroll
            for (int m = 0; m < 4; ++m) rsv[ai][m] = rstd_from(ssq, row0 + ai * HALF + m * 16);
#pragma unroll
        for (int ai = 0; ai < 2; ++ai)
#pragma unroll
            for (int m = 0; m < 4; ++m) {
                const int r = row0 + ai * HALF + m * 16; const float rs = rsv[ai][m];
#pragma unroll
                for (int bj = 0; bj < 2; ++bj) {
                    const f32x4 v0 = acc[ai][bj][m][0] * rs, v1 = acc[ai][bj][m][1] * rs;
                    u32x4 pk = {cvt_pk_bf16(v0[0], v0[1]), cvt_pk_bf16(v0[2], v0[3]), cvt_pk_bf16(v1[0], v1[1]), cvt_pk_bf16(v1[2], v1[3])};
                    *(GAS u32x4*)((GAS bf16_t*)O + (size_t)r * ldc + col0 + bj * HALF) = pk;
                }
            }
    }
};
struct EpiResid {
    static constexpr bool PERM = false;
    const float* resid; float* xo; bf16_t* xb; u64* ssq; float alpha;
    __device__ __forceinline__ void operator()(const f32x4 (&acc)[2][2][4][2], const Unit& u, int wr, int wc, int fr, int fq) const {
        const int row0 = u.pm * BM + wr * 64 + fr, col0 = u.pn * BM + wc * 32 + 4 * fq;
        const GAS float* rsd = (const GAS float*)resid; GAS float* xog = (GAS float*)xo; GAS bf16_t* xbg = (GAS bf16_t*)xb;
        f32x4 rv[2][4];
#pragma unroll
        for (int q = 0; q < 4; ++q) rv[0][q] = *(const GAS f32x4*)(rsd + (size_t)row0 * D_ + col0 + (q >> 1) * HALF + (q & 1) * 16);
#pragma unroll
        for (int gi = 0; gi < 8; ++gi) {
            const int ai = gi >> 2, m = gi & 3, r = row0 + ai * HALF + m * 16;
            if (gi < 7) { const int rn = row0 + ((gi + 1) >> 2) * HALF + ((gi + 1) & 3) * 16;
#pragma unroll
                for (int q = 0; q < 4; ++q) rv[(gi + 1) & 1][q] = *(const GAS f32x4*)(rsd + (size_t)rn * D_ + col0 + (q >> 1) * HALF + (q & 1) * 16); }
            float ss = 0.f;
#pragma unroll
            for (int bj = 0; bj < 2; ++bj)
#pragma unroll
                for (int n = 0; n < 2; ++n) {
                    const size_t o = (size_t)r * D_ + col0 + bj * HALF + n * 16;
                    const f32x4 v = rv[gi & 1][bj * 2 + n] + acc[ai][bj][m][n] * alpha;
                    *(GAS f32x4*)(xog + o) = v;
                    ss += v[0] * v[0] + v[1] * v[1] + v[2] * v[2] + v[3] * v[3];
                    if (xb) { u32x2 pk = {cvt_pk_bf16(v[0], v[1]), cvt_pk_bf16(v[2], v[3])}; *(GAS u32x2*)(xbg + (size_t)r * LD2 + col0 + bj * HALF + n * 16) = pk; }
                }
            ss += __shfl_xor(ss, 16); ss += __shfl_xor(ss, 32);
            if (fq == 0) atomicAdd((unsigned long long*)(ssq + r), (unsigned long long)ssq_fix(ss));
        }
    }
};
struct EpiFinal {
    static constexpr bool PERM = false;
    const float* resid; float* y; u64* ssq; unsigned* cnt; const float* gain; float alpha;
    __device__ __forceinline__ void operator()(const f32x4 (&acc)[2][2][4][2], const Unit& u, int wr, int wc, int fr, int fq) const {
        const int row0 = u.pm * BM + wr * 64 + fr, col0 = u.pn * BM + wc * 32 + 4 * fq;
        const GAS float* rsd = (const GAS float*)resid; GAS float* yg = (GAS float*)y;
        f32x4 v[8][4];
#pragma unroll
        for (int ai = 0; ai < 2; ++ai) {
            f32x4 rv[4][4];
#pragma unroll
            for (int m = 0; m < 4; ++m)
#pragma unroll
                for (int q = 0; q < 4; ++q) rv[m][q] = *(const GAS f32x4*)(rsd + (size_t)(row0 + ai * HALF + m * 16) * D_ + col0 + (q >> 1) * HALF + (q & 1) * 16);
#pragma unroll
            for (int m = 0; m < 4; ++m) {
                const int r = row0 + ai * HALF + m * 16; float ss = 0.f;
#pragma unroll
                for (int q = 0; q < 4; ++q) { const f32x4 t = rv[m][q] + acc[ai][q >> 1][m][q & 1] * alpha; v[ai * 4 + m][q] = t; ss += t[0] * t[0] + t[1] * t[1] + t[2] * t[2] + t[3] * t[3]; }
                ss += __shfl_xor(ss, 16); ss += __shfl_xor(ss, 32);
                if (fq == 0) atomicAdd((unsigned long long*)(ssq + r), (unsigned long long)ssq_fix(ss));
            }
        }
        asm volatile("s_waitcnt vmcnt(0)" ::: "memory");
        unsigned* c = cnt + (u.pm * 2 + wr) * 64;
        if (fr == 0 && fq == 0) (void)__hip_atomic_fetch_add(c, 1u, __ATOMIC_RELAXED, __HIP_MEMORY_SCOPE_AGENT);
        for (unsigned spins = 0; (unsigned)__builtin_amdgcn_readfirstlane(__hip_atomic_load(c, __ATOMIC_RELAXED, __HIP_MEMORY_SCOPE_AGENT)) < 32u; ) {
            __builtin_amdgcn_s_sleep(1); if (++spins > (1u << 16)) break;
        }
        f32x4 gn[4];
#pragma unroll
        for (int q = 0; q < 4; ++q) gn[q] = *(const GAS f32x4*)((const GAS float*)gain + col0 + (q >> 1) * HALF + (q & 1) * 16);
        float rs[8];
#pragma unroll
        for (int gi = 0; gi < 8; ++gi) { const int r = row0 + (gi >> 2) * HALF + (gi & 3) * 16;
            const u64 sv = __hip_atomic_load((unsigned long long*)(ssq + r), __ATOMIC_RELAXED, __HIP_MEMORY_SCOPE_AGENT);
            rs[gi] = rsqrtf((float)sv * (1.0f / 16777216.0f) * (1.0f / 2048.0f) + EPS_); }
#pragma unroll
        for (int gi = 0; gi < 8; ++gi) { const int r = row0 + (gi >> 2) * HALF + (gi & 3) * 16;
#pragma unroll
            for (int q = 0; q < 4; ++q) *(GAS f32x4*)(yg + (size_t)r * D_ + col0 + (q >> 1) * HALF + (q & 1) * 16) = v[gi][q] * rs[gi] * gn[q]; }
    }
};
struct EpiMemKV {
    static constexpr bool PERM = false;
    float* O; const u64* ssq;
    __device__ __forceinline__ void operator()(const f32x4 (&acc)[2][2][4][2], const Unit& u, int wr, int wc, int fr, int fq) const {
        const int row0 = u.pm * BM + wr * 64 + fr, col0 = u.pn * BM + wc * 32 + 4 * fq;
#pragma unroll
        for (int ai = 0; ai < 2; ++ai)
#pragma unroll
            for (int m = 0; m < 4; ++m) {
                const int r = row0 + ai * HALF + m * 16; const float rs = rstd_from(ssq, r);
#pragma unroll
                for (int bj = 0; bj < 2; ++bj)
#pragma unroll
                    for (int n = 0; n < 2; ++n) *(f32x4*)(O + (size_t)r * 1024 + col0 + bj * HALF + n * 16) = acc[ai][bj][m][n] * rs;
            }
    }
};
struct EpiCmp1 {
    static constexpr bool PERM = false;
    float* O; const float* bias;
    __device__ __forceinline__ void operator()(const f32x4 (&acc)[2][2][4][2], const Unit& u, int wr, int wc, int fr, int fq) const {
        const int row0 = u.pm * BM + wr * 64 + fr, col0 = wc * 32 + 4 * fq;
#pragma unroll
        for (int ai = 0; ai < 2; ++ai)
#pragma unroll
            for (int m = 0; m < 4; ++m) {
                const int r = row0 + ai * HALF + m * 16;
#pragma unroll
                for (int bj = 0; bj < 2; ++bj)
#pragma unroll
                    for (int n = 0; n < 2; ++n) {
                        const int c = col0 + bj * HALF + n * 16; const f32x4 b = *(const f32x4*)(bias + c); f32x4 v = acc[ai][bj][m][n] + b;
                        v[0] = silu_f(v[0]); v[1] = silu_f(v[1]); v[2] = silu_f(v[2]); v[3] = silu_f(v[3]);
                        *(f32x4*)(O + (size_t)r * 256 + c) = v;
                    }
            }
    }
};

template <class SrcF>
__device__ __forceinline__ void transpose_convert(SrcF srcf, const float* gain, bf16_t* dst, int K, int N, int ldd, int blk, int nblk) {
    LAS float* tile = (LAS float*)smem_raw;
    int t = threadIdx.x; asm volatile("" : "+v"(t));
    const int tilesK = K / 64, total = tilesK * (N / 128);
    const float* anyvalid = srcf(0, 0);
    f32x4 va[4], vb[4]; float ga[4], gb[4];
    const GAS float* gsrc = (const GAS float*)(gain ? gain : anyvalid);
    auto load_tile = [&](int it, f32x4 (&v)[4], float (&g)[4]) {
        const int tk = it % tilesK, tn = it / tilesK, k0 = tk * 64, n0 = tn * 128;
#pragma unroll
        for (int i = 0; i < 4; ++i) { const int idx = t + i * 512, k = idx >> 5, c4 = (idx & 31) * 4; const float* sp = srcf(k0 + k, n0 + c4);
            sp = sp ? sp : anyvalid;
            v[i] = __builtin_nontemporal_load((const GAS f32x4*)sp);
            g[i] = gsrc[k0 + k]; }
    };
    auto emit = [&](int it, const f32x4 (&v)[4], const float (&g)[4], LAS float* tl) {
        const int tk = it % tilesK, tn = it / tilesK, k0 = tk * 64, n0 = tn * 128;
#pragma unroll
        for (int i = 0; i < 4; ++i) { const int idx = t + i * 512, k = idx >> 5, c4 = (idx & 31) * 4;
            const float sc = (srcf(k0 + k, n0 + c4) == nullptr) ? 0.f : (gain ? g[i] : 1.f);
#pragma unroll
            for (int e = 0; e < 4; ++e) tl[(c4 + e) * 65 + k] = v[i][e] * sc; }
        __syncthreads();
        const int n = t >> 2, k16 = (t & 3) * 16; const LAS float* tp = tl + n * 65 + k16;
        u32x4 p0 = {cvt_pk_bf16(tp[0], tp[1]), cvt_pk_bf16(tp[2], tp[3]), cvt_pk_bf16(tp[4], tp[5]), cvt_pk_bf16(tp[6], tp[7])};
        u32x4 p1 = {cvt_pk_bf16(tp[8], tp[9]), cvt_pk_bf16(tp[10], tp[11]), cvt_pk_bf16(tp[12], tp[13]), cvt_pk_bf16(tp[14], tp[15])};
        GAS bf16_t* dp = (GAS bf16_t*)dst + (size_t)(n0 + n) * ldd + k0 + k16;
        *(GAS u32x4*)dp = p0; *(GAS u32x4*)(dp + 8) = p1;
    };
    int it = blk;
    if (it < total) load_tile(it, va, ga);
    if (it + nblk < total) load_tile(it + nblk, vb, gb);
    __syncthreads();
    for (; it < total; it += 2 * nblk) {
        emit(it, va, ga, tile);
        if (it + 2 * nblk < total) load_tile(it + 2 * nblk, va, ga);
        if (it + nblk < total) {
            emit(it + nblk, vb, gb, tile + 128 * 65);
            if (it + 3 * nblk < total) load_tile(it + 3 * nblk, vb, gb);
        }
    }
    __syncthreads();
}
__device__ __forceinline__ int win_src_col(int n) {
    if (n < 1536) return n;
    if (n < 4096) return n + 16;
    if (n < 4608) return n + 40;
    if (n < 4624) return n - 4608 + 1536;
    if (n < 4648) return n - 4624 + 4112;
    return -1;
}
__device__ void convert_ffn_weights(const float* wg, const float* wu, const float* wd, const float* gain, unsigned char* ws, int blk, int nblk) {
    transpose_convert([=](int k, int n) { const int p = n >> 8, half = (n >> 7) & 1, j = n & 127; const float* s = half ? wu : wg; return s + ((size_t)k * FF_ + p * 128 + j); },
                      gain, (bf16_t*)(ws + OFF_WFF), 2048, 11264, LD2, blk, nblk);
    transpose_convert([=](int k, int n) { return wd + ((size_t)k * D_ + n); }, nullptr, (bf16_t*)(ws + OFF_WD), FF_, 2048, LDF, blk, nblk);
}

constexpr int KT_BYTES = 64 * 256, VT_BYTES = 128 * 128, ABUF = KT_BYTES + VT_BYTES;
constexpr int A_IMP = 2 * ABUF;
constexpr int A_SCL = A_IMP + 65536;
constexpr int A_BM = A_SCL + 4096;
constexpr int A_UN = A_BM + 1024;
static_assert(A_UN + 64 <= LDS_BYTES, "LDS");
__host__ __device__ constexpr int vperm(int k) { return 8 * (4 * (k >> 5) + ((k >> 2) & 3)) + 4 * ((k >> 4) & 1) + (k & 3); }
__host__ __device__ constexpr int vperm_inv(int n) { return 32 * (n >> 5) + 16 * ((n >> 2) & 1) + 4 * ((n >> 3) & 3) + (n & 3); }
constexpr float SM_SCALE = 0.08838834764831845f;
constexpr float QSCALE = 0.08838834764831845f * 1.4426950408889634f;

__device__ __forceinline__ void attn_dma_k(const bf16_t* Kb, int tile, LAS unsigned char* buf, int wv, int lane) {
#pragma unroll
    for (int i = 0; i < 2; ++i) {
        const int row = (i * 8 + wv) * 4 + (lane >> 4), ch = (lane & 15) ^ (row & 15);
        __builtin_amdgcn_global_load_lds((const unsigned*)(Kb + ((size_t)(tile * 64 + row) * 128 + ch * 8)), (LAS unsigned*)(buf + (i * 8 + wv) * 1024), 16, 0, 0);
    }
}
__device__ __forceinline__ void attn_dma_v(const bf16_t* Vt, int ldv, int tile, LAS unsigned char* buf, int wv, int lane) {
#pragma unroll
    for (int i = 0; i < 2; ++i) {
        const int row = (i * 8 + wv) * 8 + (lane >> 3), ch = (lane & 7) ^ ((row >> 1) & 7);
        __builtin_amdgcn_global_load_lds((const unsigned*)(Vt + ((size_t)row * ldv + tile * 64 + ch * 8)), (LAS unsigned*)(buf + KT_BYTES + (i * 8 + wv) * 1024), 16, 0, 0);
    }
}
template <int NG>
__device__ __forceinline__ void attn_qk(LAS unsigned char* kbuf, const bf16x8 (&qf)[NG][4], f32x4 (&s)[NG][4], int fr, int fq, float negB) {
#pragma unroll
    for (int g = 0; g < NG; ++g)
#pragma unroll
        for (int nb = 0; nb < 4; ++nb) s[g][nb] = (f32x4){negB, negB, negB, negB};
    bf16x8 kf[2][4];
#pragma unroll
    for (int kk = 0; kk < 4; ++kk) kf[0][kk] = *(const LAS bf16x8*)(kbuf + fr * 256 + (((kk * 4 + fq) ^ fr) << 4));
#pragma unroll
    for (int nb = 0; nb < 4; ++nb) {
        if (nb < 3) {
#pragma unroll
            for (int kk = 0; kk < 4; ++kk) kf[(nb + 1) & 1][kk] = *(const LAS bf16x8*)(kbuf + ((nb + 1) * 16 + fr) * 256 + (((kk * 4 + fq) ^ fr) << 4));
        }
        __builtin_amdgcn_sched_barrier(0);
#pragma unroll
        for (int kk = 0; kk < 4; ++kk)
#pragma unroll
            for (int g = 0; g < NG; ++g) s[g][nb] = __builtin_amdgcn_mfma_f32_16x16x32_bf16(kf[nb & 1][kk], qf[g][kk], s[g][nb], 0, 0, 0);
        __builtin_amdgcn_sched_barrier(0);
    }
}
template <int NG, int NBUF, class MaskF, class NextF, class KindF, class OnF>
__device__ __forceinline__ void attn_core(const bf16_t* Kb, const bf16_t* Vt, int ldv, const bf16x8 (&qf)[NG][4], int first, int end, NextF next_tile, MaskF mask, KindF kind, OnF lane_on,
                                          float negB, f32x4 (&O)[NG][8], float (&lrow)[NG]) {
    LAS unsigned char* lds = (LAS unsigned char*)smem_raw;
    const int lane = threadIdx.x & 63, fr = lane & 15, fq = lane >> 4;
#pragma unroll
    for (int g = 0; g < NG; ++g) { lrow[g] = 0.f;
#pragma unroll
        for (int db = 0; db < 8; ++db) O[g][db] = (f32x4){0.f, 0.f, 0.f, 0.f}; }
    constexpr int D = NBUF - 1;
    int tl[NBUF];
    tl[0] = first;
#pragma unroll
    for (int d = 1; d <= D; ++d) tl[d] = (tl[d - 1] < end) ? next_tile(tl[d - 1]) : end;
    if (tl[0] < end) {
        const int wvu = __builtin_amdgcn_readfirstlane(threadIdx.x >> 6);
        asm volatile("s_waitcnt vmcnt(0)" ::: "memory");
#pragma unroll
        for (int d = 0; d < D; ++d) if (tl[d] < end) { attn_dma_k(Kb, tl[d], lds + d * ABUF, wvu, lane); attn_dma_v(Vt, ldv, tl[d], lds + d * ABUF, wvu, lane); }
        int slot = 0;
        for (;;) {
            const int kt = tl[0];
            LAS unsigned char* B = lds + slot * ABUF;
            int nf = 0;
#pragma unroll
            for (int d = 1; d < D; ++d) nf += (tl[d] < end) ? 1 : 0;
            if (D >= 2 && nf >= 2) asm volatile("s_waitcnt vmcnt(8)" ::: "memory");
            else if (D >= 2 && nf == 1) asm volatile("s_waitcnt vmcnt(4)" ::: "memory");
            else asm volatile("s_waitcnt vmcnt(0)" ::: "memory");
            asm volatile("s_waitcnt lgkmcnt(0)" ::: "memory");
            __builtin_amdgcn_s_barrier();
            asm volatile("" ::: "memory");
            if (tl[D] < end) { int ns = slot + D; if (ns >= NBUF) ns -= NBUF; LAS unsigned char* Bn = lds + ns * ABUF; attn_dma_k(Kb, tl[D], Bn, wvu, lane); attn_dma_v(Vt, ldv, tl[D], Bn, wvu, lane); }
            f32x4 s[NG][4];
            attn_qk<NG>(B, qf, s, fr, fq, negB);
            __builtin_amdgcn_sched_barrier(0);
            bf16x8 pf[NG][2];
            const bool masked = kind(kt);
            const bool on = lane_on(kt);
#pragma unroll
            for (int g = 0; g < NG; ++g) {
                float ps = 0.f;
#pragma unroll
                for (int nb = 0; nb < 4; ++nb)
#pragma unroll
                    for (int j = 0; j < 4; ++j) s[g][nb][j] = __builtin_amdgcn_exp2f(s[g][nb][j]);
                if (masked) {
#pragma unroll
                    for (int nb = 0; nb < 4; ++nb)
#pragma unroll
                        for (int j = 0; j < 4; ++j) { const int key = kt * 64 + nb * 16 + fq * 4 + j; s[g][nb][j] = mask(g, key) ? s[g][nb][j] : 0.f; }
                }
#pragma unroll
                for (int nb = 0; nb < 4; ++nb) ps += (s[g][nb][0] + s[g][nb][1]) + (s[g][nb][2] + s[g][nb][3]);
                lrow[g] += on ? ps : 0.f;
#pragma unroll
                for (int p = 0; p < 2; ++p) {
                    union { u32x4 u; bf16x8 b; } cv;
                    cv.u = (u32x4){cvt_pk_bf16(s[g][2 * p][0], s[g][2 * p][1]), cvt_pk_bf16(s[g][2 * p][2], s[g][2 * p][3]),
                                   cvt_pk_bf16(s[g][2 * p + 1][0], s[g][2 * p + 1][1]), cvt_pk_bf16(s[g][2 * p + 1][2], s[g][2 * p + 1][3])};
                    if (!on) cv.u = (u32x4){0u, 0u, 0u, 0u};
                    pf[g][p] = cv.b;
                }
            }
            __builtin_amdgcn_sched_barrier(0);
            {
                union VF { struct { u32x2 a, b; } h; bf16x8 v; };
                VF vf[2][2];
                const LAS unsigned char* vbase = B + KT_BYTES + fr * 128; const int sw = (fr >> 1) & 7;
#pragma unroll
                for (int p = 0; p < 2; ++p) vf[0][p].v = *(const LAS bf16x8*)(vbase + (((4 * p + fq) ^ sw) << 4));
#pragma unroll
                for (int db = 0; db < 8; ++db) {
                    if (db < 7) {
#pragma unroll
                        for (int p = 0; p < 2; ++p) vf[(db + 1) & 1][p].v = *(const LAS bf16x8*)(vbase + (db + 1) * 2048 + (((4 * p + fq) ^ sw) << 4));
                    }
                    __builtin_amdgcn_sched_barrier(0);
#pragma unroll
                    for (int p = 0; p < 2; ++p)
#pragma unroll
                        for (int g = 0; g < NG; ++g) O[g][db] = __builtin_amdgcn_mfma_f32_16x16x32_bf16(vf[db & 1][p].v, pf[g][p], O[g][db], 0, 0, 0);
                    __builtin_amdgcn_sched_barrier(0);
                }
            }
            const int last = tl[D];
#pragma unroll
            for (int d = 0; d < D; ++d) tl[d] = tl[d + 1];
            tl[D] = (last < end) ? next_tile(last) : end;
            if (tl[0] >= end) break;
            ++slot; if (slot >= NBUF) slot = 0;
        }
    }
    asm volatile("s_waitcnt vmcnt(0)" ::: "memory");
    __syncthreads();
}
__device__ __forceinline__ float score_neg_bound(const float* gq, const float* gk) {
    const int lane = threadIdx.x & 63;
    float a = fmaxf(fabsf(gq[lane]), fabsf(gq[lane + 64])), b = fmaxf(fabsf(gk[lane]), fabsf(gk[lane + 64]));
#pragma unroll
    for (int o = 32; o >= 1; o >>= 1) { a = fmaxf(a, __shfl_xor(a, o)); b = fmaxf(b, __shfl_xor(b, o)); }
    return -(a * b * 128.0f * QSCALE * 1.02f);
}
__device__ __forceinline__ void load_qf(bf16x8 (&qf)[4], const bf16_t* qrow, int fq) {
#pragma unroll
    for (int kk = 0; kk < 4; ++kk) qf[kk] = *(const GAS bf16x8*)((const GAS bf16_t*)qrow + kk * 32 + fq * 8);
}

#define WFF ((bf16_t*)(wsp + OFF_WFF))
#define WD ((bf16_t*)(wsp + OFF_WD))
#define WIN ((bf16_t*)(wsp + OFF_WIN))
#define WOUT ((bf16_t*)(wsp + OFF_WOUT))
#define WMEM ((bf16_t*)(wsp + OFF_WMEM))
#define WC1 ((bf16_t*)(wsp + OFF_WC1))
#define ACT ((bf16_t*)(wsp + OFF_ACT))
#define XB ((bf16_t*)(wsp + OFF_XB))
#define MIX ((bf16_t*)(wsp + OFF_MIX))
#define X2 ((float*)(wsp + OFF_X2))
#define QN ((bf16_t*)(wsp + OFF_QN))
#define KSN ((bf16_t*)(wsp + OFF_KSN))
#define KWN ((bf16_t*)(wsp + OFF_KWN))
#define VST ((bf16_t*)(wsp + OFF_VST))
#define VWT ((bf16_t*)(wsp + OFF_VWT))
#define KCB ((bf16_t*)(wsp + OFF_KCB))
#define VCB ((bf16_t*)(wsp + OFF_VCB))
#define MQN ((bf16_t*)(wsp + OFF_MQN))
#define LA ((float*)(wsp + OFF_LA))
#define GATE ((float*)(wsp + OFF_GATE))
#define ONSA ((float*)(wsp + OFF_ONSA))
#define OCMP ((float*)(wsp + OFF_XB))
#define GLAS ((float*)(wsp + OFF_GLAS))
#define ROPEC ((float*)(wsp + OFF_ROPE))
#define SSQ0 ((u64*)(wsp + OFF_SSQ))
#define SSQM ((u64*)(wsp + OFF_SSQM))
#define MEMB ((bf16_t*)(wsp + OFF_MEMB))
#define KVMEM ((float*)(wsp + OFF_KVMEM))
#define MEMK ((bf16_t*)(wsp + OFF_MEMK))
#define MEMVT ((bf16_t*)(wsp + OFF_MEMVT))
#define HID ((float*)(wsp + OFF_HID))
#define C2 ((float*)(wsp + OFF_C2))
#define KCMP ((bf16_t*)(wsp + OFF_KCMP))
#define VCMPT ((bf16_t*)(wsp + OFF_VCMPT))
#define SEL ((unsigned*)(wsp + OFF_SEL))
#define DEC ((float*)(wsp + OFF_DEC))
#define CBIAS ((float*)(wsp + OFF_CBIAS))
#define PROJ ACT
#define X1 (p.out)
#define X3 (p.out)
#define ROPES (ROPEC + (size_t)S_ * 64)
#define SSQ1 (SSQ0 + S_)
#define SSQ2 (SSQ0 + 2 * S_)
#define SSQ3 (SSQ0 + 3 * S_)
__global__ void __launch_bounds__(512, 2) mega(Params p) {
    cg::grid_group grid = cg::this_grid();
    if (p.ws == nullptr) grid.sync();
    {
        volatile LAS unsigned* stw = (volatile LAS unsigned*)((LAS unsigned char*)smem_raw + LDS_MAIN);
        if (threadIdx.x < 4) stw[threadIdx.x] = 0u;
        __syncthreads();
    }
    const XcdBarrier xbar = xcd_barrier_post((unsigned*)(p.ws + OFF_BAR), (volatile LAS unsigned*)((LAS unsigned char*)smem_raw + LDS_MAIN));
    LAS unsigned char* lds = (LAS unsigned char*)smem_raw;
    const int nblk = gridDim.x, nwaves = nblk * 8, nthreads = nblk * 512;
    int blk;
    {
        __syncthreads();
        const unsigned rank = ((volatile LAS unsigned*)((LAS unsigned char*)smem_raw + LDS_MAIN))[2];
        blk = (nblk == 256 && xbar.x < 8u && rank < 32u) ? (int)(rank * 8u + xbar.x) : (int)blockIdx.x;
        blk = __builtin_amdgcn_readfirstlane(blk);
    }
#define PHASE_IDS unsigned char* wsp = p.ws; asm volatile("" : "+s"(wsp)); int tid = threadIdx.x; asm volatile("" : "+v"(tid)); const int lane = tid & 63, wv = tid >> 6, gwave = blk * 8 + wv, gtid = blk * 512 + tid; (void)lane; (void)wv; (void)gwave; (void)gtid;
    REPS(0) { if (rep_) xcd_barrier(xbar);
        PHASE_IDS
        convert_ffn_weights(p.ffn1_wg, p.ffn1_wu, p.ffn1_wd, p.ffn1_norm, wsp, blk, nblk);
        { const float* w = p.w_in; transpose_convert([=](int k, int n) { const int c = win_src_col(n); return c >= 0 ? w + ((size_t)k * 4648 + c) : (const float*)nullptr; }, p.mix_norm, WIN, 2048, NPJ, LD2, blk, nblk); }
        { const float* w = p.w_out; transpose_convert([=](int k, int n) { return w + ((size_t)k * 2048 + n); }, nullptr, WOUT, 2048, 2048, LD2, blk, nblk); }
        { const float* w = p.w_mem_kv; transpose_convert([=](int k, int n) { return w + ((size_t)k * 1024 + n); }, p.mem_in_norm, WMEM, 2048, 1024, LD2, blk, nblk); }
        { const float* w = p.cmp_w1_k; transpose_convert([=](int k, int n) { return w + ((size_t)k * 256 + n); }, nullptr, WC1, 4096, 256, 4096, blk, nblk); }
        { const float* w = p.cmp_w1_v; transpose_convert([=](int k, int n) { return w + ((size_t)k * 256 + n); }, nullptr, WC1 + 256 * 4096, 4096, 256, 4096, blk, nblk); }
        for (int r16 = blk * 16; r16 < S_ + MEMLEN; r16 += nblk * 16)
#pragma unroll 1
        for (int sub = 0; sub < 2; ++sub) {
            const int r = r16 + wv * 2 + sub;
            const bool ism = r >= S_; const int rr = ism ? r - S_ : r;
            const float* src = (ism ? p.mem : p.x) + (size_t)rr * D_; bf16_t* dst = (ism ? MEMB : XB) + (size_t)rr * LD2;
            float ss = 0.f; f32x4 xv[8];
#pragma unroll
            for (int i = 0; i < 8; ++i) xv[i] = __builtin_nontemporal_load((const GAS f32x4*)((const GAS float*)src + (lane + 64 * i) * 4));
#pragma unroll
            for (int i = 0; i < 8; ++i) {
                const f32x4 v = xv[i];
                ss += v[0] * v[0] + v[1] * v[1] + v[2] * v[2] + v[3] * v[3];
                u32x2 pk = {cvt_pk_bf16(v[0], v[1]), cvt_pk_bf16(v[2], v[3])}; *(GAS u32x2*)((GAS bf16_t*)dst + (lane + 64 * i) * 4) = pk;
            }
            ss = wave_sum(ss);
            if (lane == 0) { if (ism) SSQM[rr] = ssq_fix(ss); else SSQ0[rr] = ssq_fix(ss); }
        }
        for (int i = gtid; i < 3 * S_; i += nthreads) SSQ1[i] = 0ull;
        for (int i = gtid; i < 64 * 64; i += nthreads) ((unsigned*)(wsp + OFF_PCNT))[i] = 0u;
        for (int i = gtid; i < S_ * 64; i += nthreads) {
            const int tok = i >> 6, f = i & 63;
            const float inv = powf(10000.0f, -(float)f * (1.0f / 64.0f));
            const float ang = (float)p.pos[tok] * inv;
            float sn, cs; sincosf(ang, &sn, &cs);
            ROPEC[i] = cs; ROPES[i] = sn;
        }
#if NPH < 4
        for (int i = gtid; i < S_ * LD2 / 8; i += nthreads) ((u32x4*)MIX)[i] = (u32x4){0u, 0u, 0u, 0u};
        for (int i = gtid; i < S_ * 1024 / 4; i += nthreads) ((f32x4*)ONSA)[i] = (f32x4){0.f, 0.f, 0.f, 0.f};
#endif
    }
    xcd_barrier(xbar);
    REPS(1) { if (rep_) xcd_barrier(xbar);
        PHASE_IDS
        pg8::Gemm g{XB, WFF, S_, 11264, 2048, LD2, LD2}; pg8::StaticOrder so; so.init(g.M, g.N, nblk, blk);
        EpiGateUp e{ACT, SSQ0};
        pg8::gemm_phase(lds, g, so, e);
        pg8::Gemm g2{MEMB, WMEM, 256, 1024, 2048, LD2, LD2}; pg8::StaticOrder so2; so2.init(g2.M, g2.N, nblk, blk + 4 >= nblk ? blk + 4 - nblk : blk + 4);
        EpiMemKV e2{KVMEM, SSQM};
        pg8::gemm_phase(lds, g2, so2, e2);
    }
    xcd_barrier(xbar);
    {
        PHASE_IDS
        pg8::Gemm g{ACT, WD, S_, 2048, FF_, LDF, LDF}; pg8::StaticOrder so; so.init(g.M, g.N, nblk, blk);
        EpiResid e{p.x, X1, XB, SSQ1, 0.5f};
        pg8::gemm_phase(lds, g, so, e);
    }
    xcd_barrier(xbar);
    {
        PHASE_IDS
        pg8::Gemm g{XB, WIN, S_, NPJ, 2048, LD2, LD2}; pg8::StaticOrder so; so.init(g.M, g.N, nblk, blk);
        EpiScaleBf16 e{PROJ, NPJ, SSQ1};
        pg8::gemm_phase(lds, g, so, e);
    }
    xcd_barrier(xbar);
    REPS(4) { if (rep_) xcd_barrier(xbar);
        PHASE_IDS
        if (rep_ && (DUPSUB & 8)) continue;
        convert_ffn_weights(p.ffn2_wg, p.ffn2_wu, p.ffn2_wd, p.ffn2_norm, wsp, blk, nblk);
#if NPH >= 2
        for (int tok = gwave; tok < S_; tok += nwaves) {
            const GAS bf16_t* pr = (const GAS bf16_t*)(PROJ + (size_t)tok * NPJ);
            bf16_t ar[16], br[16], cr[8];
#pragma unroll
            for (int v = 0; v < 16; ++v) { const int col = (v < 8) ? PC_NQ + v * 128 : (v < 10) ? PC_KS + (v - 8) * 128 : (v < 12) ? PC_KW + (v - 10) * 128 : PC_MQ + (v - 12) * 128;
                ar[v] = pr[col + lane]; br[v] = pr[col + 64 + lane]; }
#pragma unroll
            for (int g = 0; g < 2; ++g) { cr[g * 4 + 0] = pr[PC_KC + g * 128 + lane]; cr[g * 4 + 1] = pr[PC_KC + g * 128 + 64 + lane]; cr[g * 4 + 2] = pr[PC_VC + g * 128 + lane]; cr[g * 4 + 3] = pr[PC_VC + g * 128 + 64 + lane]; }
            const float cs = ROPEC[tok * 64 + lane], sn = ROPES[tok * 64 + lane];
            const float gq0 = p.q_norm[lane], gq1 = p.q_norm[64 + lane], gs0 = p.k_norm[128 + lane], gs1 = p.k_norm[192 + lane], gw0 = p.k_norm[256 + lane], gw1 = p.k_norm[320 + lane], gm0 = p.mem_q_norm[lane], gm1 = p.mem_q_norm[64 + lane];
#pragma unroll
            for (int v = 0; v < 16; ++v) {
                GAS bf16_t* dst; float g0, g1; bool rope = true;
                if (v < 8) { g0 = gq0; g1 = gq1; dst = (GAS bf16_t*)(QN + ((size_t)v * S_ + tok) * 128); }
                else if (v < 10) { g0 = gs0; g1 = gs1; dst = (GAS bf16_t*)(KSN + ((size_t)(v - 8) * S_ + tok) * 128); }
                else if (v < 12) { g0 = gw0; g1 = gw1; dst = (GAS bf16_t*)(KWN + ((size_t)(v - 10) * S_ + tok) * 128); }
                else { g0 = gm0; g1 = gm1; dst = (GAS bf16_t*)(MQN + ((size_t)(v - 12) * S_ + tok) * 128); rope = false; }
                float a = bf2f(ar[v]), b = bf2f(br[v]);
                const float ss = wave_sum(a * a + b * b); const float r = rsqrtf(ss * (1.0f / 128.0f) + EPS_);
                a *= r * g0; b *= r * g1;
                float o1 = a, o2 = b;
                if (rope) { o1 = a * cs - b * sn; o2 = b * cs + a * sn; }
                if (v < 8 || v >= 12) { o1 *= QSCALE; o2 *= QSCALE; }
                dst[lane] = f2bf(o1); dst[64 + lane] = f2bf(o2);
            }
#pragma unroll
            for (int g = 0; g < 2; ++g) {
                GAS bf16_t* kd = (GAS bf16_t*)(KCB + ((size_t)g * S_ + tok) * 128); GAS bf16_t* vd = (GAS bf16_t*)(VCB + ((size_t)g * S_ + tok) * 128);
                kd[lane] = cr[g * 4 + 0]; kd[64 + lane] = cr[g * 4 + 1]; vd[lane] = cr[g * 4 + 2]; vd[64 + lane] = cr[g * 4 + 3];
            }
        }
        {
            PHASE_IDS
            LAS bf16_t* tl = (LAS bf16_t*)lds;
            for (int it = blk; it < 4 * 128; it += nblk) {
                const int which = it >> 8, g = (it >> 7) & 1, t0 = (it & 127) * 64;
                const int col = (which ? PC_VW : PC_VS) + g * 128; bf16_t* dstT = (which ? VWT : VST) + (size_t)g * 128 * S_;
                __syncthreads();
#pragma unroll
                for (int i = 0; i < 2; ++i) { const int c = tid + i * 512, row = c >> 4, ch = c & 15;
                    *(LAS u32x4*)(tl + row * 136 + ch * 8) = *(const GAS u32x4*)((const GAS bf16_t*)PROJ + (size_t)(t0 + row) * NPJ + col + ch * 8); }
                __syncthreads();
                { const int dv = tid >> 2, tc = (tid & 3) * 16; unsigned pk[8];
#pragma unroll
                  for (int i = 0; i < 8; ++i) pk[i] = (unsigned)tl[vperm_inv(tc + 2 * i) * 136 + dv] | ((unsigned)tl[vperm_inv(tc + 2 * i + 1) * 136 + dv] << 16);
                  *(GAS u32x4*)((GAS bf16_t*)dstT + (size_t)dv * S_ + t0 + tc) = (u32x4){pk[0], pk[1], pk[2], pk[3]};
                  *(GAS u32x4*)((GAS bf16_t*)dstT + (size_t)dv * S_ + t0 + tc + 8) = (u32x4){pk[4], pk[5], pk[6], pk[7]}; }
            }
            __syncthreads();
        }
        for (int i = gtid; i < S_ * 64; i += nthreads) {
            const int tok = i >> 6, c0 = (i & 63) * 4; const GAS bf16_t* pr = (const GAS bf16_t*)(PROJ + (size_t)tok * NPJ + PC_GA);
            const u32x4 ga0 = *(const GAS u32x4*)pr, ga1 = *(const GAS u32x4*)(pr + 8);
            f32x4 xacc = *(const GAS f32x4*)((const GAS float*)p.gla_ba + c0);
#pragma unroll
            for (int r = 0; r < 16; ++r) { const unsigned w = (r < 8) ? ga0[(r & 7) >> 1] : ga1[(r & 7) >> 1]; const float gv = (r & 1) ? __uint_as_float(w & 0xffff0000u) : __uint_as_float(w << 16);
                xacc += *(const GAS f32x4*)((const GAS float*)p.gla_wa + r * 256 + c0) * gv; }
            f32x4 o;
#pragma unroll
            for (int e = 0; e < 4; ++e) { const float xv = xacc[e]; o[e] = (fminf(xv, 0.f) - log1pf(__expf(-fabsf(xv)))) * (1.0f / 16.0f); }
            *(GAS f32x4*)((GAS float*)LA + (size_t)tok * 256 + c0) = o;
        }
        for (int i = gtid; i < S_ * 24; i += nthreads) { const int tok = i / 24, j = i % 24; GATE[i] = sigmoid_f(bf2f(PROJ[(size_t)tok * NPJ + PC_NG + j])); }
        for (int it = gwave; it < 4 * 256; it += nwaves) {
            const int h = it >> 8, m = it & 255; const float* kr = KVMEM + (size_t)m * 1024 + h * 128;
            float a = kr[lane], b = kr[64 + lane]; const float ss = wave_sum(a * a + b * b); const float r = rsqrtf(ss * (1.0f / 128.0f) + EPS_);
            MEMK[((size_t)h * 256 + m) * 128 + lane] = f2bf(a * r * p.mem_k_norm[lane]); MEMK[((size_t)h * 256 + m) * 128 + 64 + lane] = f2bf(b * r * p.mem_k_norm[64 + lane]);
        }
        for (int i = gtid; i < 4 * 128 * 256; i += nthreads) { const int m = i & 255, dv = (i >> 8) & 127, h = i >> 15; MEMVT[(i & ~63) | vperm(i & 63)] = f2bf(KVMEM[(size_t)m * 1024 + 512 + h * 128 + dv]); }
        for (int it = gwave; it < 512; it += nwaves) {
            const int kv = it >> 8, c = it & 255; const float* pf = kv ? p.cmp_pos_v : p.cmp_pos_k; const bf16_t* wr_ = WC1 + ((size_t)kv * 256 + c) * 4096;
            float s = 0.f;
            for (int k = lane; k < 4096; k += 64) s += pf[k] * bf2f(wr_[k]);
            s = wave_sum(s); if (lane == 0) CBIAS[it * 32] = s;
        }
#endif
    }
    xcd_barrier(xbar);
    REPS(5) { if (rep_) xcd_barrier(xbar);
        PHASE_IDS
#if NPH >= 4
        if (!rep_ || (DUPSUB & 1))
        for (int it = (blk >= 128 ? blk - 128 : blk + nblk - 128); it < 128; it += nblk) {
            PHASE_IDS
            const int fr = lane & 15, fq = lane >> 4;
            const int combo = it >> 5, kv = combo >> 1, g = combo & 1, r0 = (it & 31) * 16;
            const bf16_t* A = (kv ? VCB : KCB) + (size_t)g * S_ * 128 + (size_t)r0 * 2048 + (size_t)fr * 2048 + wv * 512 + fq * 8;
            const bf16_t* W = WC1 + (size_t)kv * 256 * 4096 + (size_t)fr * 4096 + wv * 512 + fq * 8;
            f32x4 acc[16];
#pragma unroll
            for (int n = 0; n < 16; ++n) acc[n] = (f32x4){0.f, 0.f, 0.f, 0.f};
#pragma unroll 1
            for (int ks = 0; ks < 16; ++ks) {
                const bf16x8 af = *(const GAS bf16x8*)((const GAS bf16_t*)A + ks * 32);
#pragma unroll
                for (int n = 0; n < 16; ++n) { const bf16x8 bfv = *(const GAS bf16x8*)((const GAS bf16_t*)W + (size_t)n * 16 * 4096 + ks * 32); acc[n] = __builtin_amdgcn_mfma_f32_16x16x32_bf16(af, bfv, acc[n], 0, 0, 0); }
            }
            LAS float* part = (LAS float*)lds; LAS float* hidL = (LAS float*)(lds + 131072);
            __syncthreads();
#pragma unroll
            for (int n = 0; n < 16; ++n)
#pragma unroll
                for (int j = 0; j < 4; ++j) part[(wv * 16 + fq * 4 + j) * 256 + n * 16 + fr] = acc[n][j];
            __syncthreads();
#pragma unroll
            for (int i = 0; i < 8; ++i) { const int idx = tid + i * 512, r = idx >> 8, c = idx & 255; float sacc = CBIAS[(kv * 256 + c) * 32];
#pragma unroll
                for (int w = 0; w < 8; ++w) sacc += part[(w * 16 + r) * 256 + c];
                hidL[idx] = silu_f(sacc); }
            __syncthreads();
            {
                const int r = tid >> 5, c4 = (tid & 31) * 4, n = r0 + r; const float* w2 = (kv ? p.cmp_w2_v : p.cmp_w2_k) + c4;
                f32x4 o = (f32x4){0.f, 0.f, 0.f, 0.f};
#pragma unroll 8
                for (int k = 0; k < 256; ++k) { const float hv = hidL[r * 256 + k]; const f32x4 w = *(const GAS f32x4*)((const GAS float*)w2 + k * 128); o += w * hv; }
                if (n >= 511) o = (f32x4){0.f, 0.f, 0.f, 0.f};
                if (kv == 0) {
                    float ss = o[0] * o[0] + o[1] * o[1] + o[2] * o[2] + o[3] * o[3];
                    ss += __shfl_xor(ss, 1); ss += __shfl_xor(ss, 2); ss += __shfl_xor(ss, 4); ss += __shfl_xor(ss, 8); ss += __shfl_xor(ss, 16);
                    const float rs = rsqrtf(ss * (1.0f / 128.0f) + EPS_);
                    const f32x4 gn = *(const f32x4*)(p.k_norm + c4); o = o * rs * gn;
                    f32x4 pr; pr[0] = __shfl_xor(o[0], 16); pr[1] = __shfl_xor(o[1], 16); pr[2] = __shfl_xor(o[2], 16); pr[3] = __shfl_xor(o[3], 16);
                    const int tk = (n < 511) ? 16 * n + 31 : 0; const int fi = c4 & 63;
                    const f32x4 cs = *(const f32x4*)(ROPEC + tk * 64 + fi), sn = *(const f32x4*)(ROPES + tk * 64 + fi);
                    f32x4 res;
                    if (c4 < 64) res = o * cs - pr * sn; else res = o * cs + pr * sn;
                    u32x2 pk = {cvt_pk_bf16(res[0], res[1]), cvt_pk_bf16(res[2], res[3])};
                    *(u32x2*)(KCMP + ((size_t)g * 512 + n) * 128 + c4) = pk;
                } else {
#pragma unroll
                    for (int j = 0; j < 4; ++j) { const unsigned mine = f2bf(o[j]); const unsigned oth = __shfl_xor(mine, 32);
                        if (lane < 32) __hip_atomic_store((unsigned*)(VCMPT + ((size_t)g * 128 + c4 + j) * 512 + ((n & ~63) | vperm(n & 63))), mine | (oth << 16), __ATOMIC_RELAXED, __HIP_MEMORY_SCOPE_AGENT); }
                }
            }
            __syncthreads();
        }
#endif
#if NPH >= 3
        if (!rep_ || (DUPSUB & 2))
        for (int it = blk; it < 256 + 128; it += nblk) {
            PHASE_IDS
            const int fr = lane & 15, fq = lane >> 4;
            bf16x8 qf[2][4]; f32x4 O[2][8]; float lrow[2];
            if (it < 256) {
                const int g = it >> 7, t0 = (it & 127) * 64; const int tg = wv & 3, hp = wv >> 2; const int tok = t0 + tg * 16 + fr;
#pragma unroll
                for (int q = 0; q < 2; ++q) load_qf(qf[q], QN + ((size_t)(g * 4 + hp * 2 + q) * S_ + tok) * 128, fq);
                const int first = (t0 >= 512) ? (t0 >> 6) - 8 : 0, end = (t0 >> 6) + 1;
                attn_core<2, 4>(KWN + (size_t)g * S_ * 128, VWT + (size_t)g * 128 * S_, S_, qf, first, end, [](int kt) { return kt + 1; },
                          [=](int, int key) { return key <= tok && key > tok - 512; }, [=](int kt) { return kt == end - 1 || (t0 >= 512 && kt == first); }, [](int) { return true; },
                          score_neg_bound(p.q_norm, p.k_norm + 256), O, lrow);
#pragma unroll
                for (int q = 0; q < 2; ++q) {
                    float l = lrow[q]; l += __shfl_xor(l, 16); l += __shfl_xor(l, 32);
                    const int hl = hp * 2 + q; const float sc = ((const GAS float*)GATE)[tok * 24 + g * 12 + hl * 3 + 2] / fmaxf(l, 1e-30f);
#pragma unroll
                    for (int db = 0; db < 8; ++db) *(GAS f32x4*)((GAS float*)ONSA + (size_t)tok * 1024 + (g * 4 + hl) * 128 + db * 16 + fq * 4) = O[q][db] * sc;
                }
            } else {
                const int im = it - 256, h = im >> 5, t0 = (im & 31) * 256; int tokq[2];
#pragma unroll
                for (int q = 0; q < 2; ++q) { tokq[q] = t0 + wv * 32 + q * 16 + fr; load_qf(qf[q], MQN + ((size_t)h * S_ + tokq[q]) * 128, fq); }
                attn_core<2, 4>(MEMK + (size_t)h * 256 * 128, MEMVT + (size_t)h * 128 * 256, 256, qf, 0, 4, [](int kt) { return kt + 1; },
                          [](int, int) { return true; }, [](int) { return false; }, [](int) { return true; }, score_neg_bound(p.mem_q_norm, p.mem_k_norm), O, lrow);
#pragma unroll
                for (int q = 0; q < 2; ++q) {
                    float l = lrow[q]; l += __shfl_xor(l, 16); l += __shfl_xor(l, 32); const float sc = 1.0f / fmaxf(l, 1e-30f);
#pragma unroll
                    for (int db = 0; db < 8; ++db) { const f32x4 v = O[q][db] * sc; u32x2 pk = {cvt_pk_bf16(v[0], v[1]), cvt_pk_bf16(v[2], v[3])};
                        *(GAS u32x2*)((GAS bf16_t*)MIX + (size_t)tokq[q] * LD2 + 1536 + h * 128 + db * 16 + fq * 4) = pk; }
                }
            }
        }
#endif
#if NPH >= 2
        if (!rep_ || (DUPSUB & 4))
        {
            PHASE_IDS
            LAS float* Bc = (LAS float*)lds; LAS float* Kt = Bc + 4096; LAS float* Vv = Kt + 4096;
            for (int it = blk; it < 512; it += nblk) {
                const int h = it >> 7, c = it & 127, tk0 = c * 64;
                __syncthreads();
                for (int i = tid; i < 4096; i += 512) Bc[i] = ((const GAS float*)LA)[(size_t)(tk0 + (i >> 6)) * 256 + h * 64 + (i & 63)];
                u32x4 kraw, vraw[2];
                { const int j = tid >> 3, d8 = (tid & 7) * 8; kraw = *(const GAS u32x4*)((const GAS bf16_t*)PROJ + (size_t)(tk0 + j) * NPJ + PC_GK + h * 64 + d8); }
#pragma unroll
                for (int q = 0; q < 2; ++q) { const int cix = tid + q * 512, j = cix >> 4, e8 = (cix & 15) * 8; vraw[q] = *(const GAS u32x4*)((const GAS bf16_t*)PROJ + (size_t)(tk0 + j) * NPJ + PC_GV + h * 128 + e8); }
                __syncthreads();
                if (tid < 64) { float run = 0.f; for (int i = 0; i < 64; ++i) { run += Bc[i * 64 + tid]; Bc[i * 64 + tid] = run; } DEC[(h * 128 + c) * 64 + tid] = __expf(run); }
                __syncthreads();
                { const int j = tid >> 3, d8 = (tid & 7) * 8;
#pragma unroll
                  for (int e = 0; e < 4; ++e) { const unsigned w = kraw[e]; const int d = d8 + 2 * e;
                      Kt[j * 64 + d] = __uint_as_float(w << 16) * __expf(Bc[63 * 64 + d] - Bc[j * 64 + d]);
                      Kt[j * 64 + d + 1] = __uint_as_float(w & 0xffff0000u) * __expf(Bc[63 * 64 + d + 1] - Bc[j * 64 + d + 1]); } }
#pragma unroll
                for (int q = 0; q < 2; ++q) { const int cix = tid + q * 512, j = cix >> 4, e8 = (cix & 15) * 8;
#pragma unroll
                    for (int e = 0; e < 4; ++e) { const unsigned w = vraw[q][e]; Vv[j * 128 + e8 + 2 * e] = __uint_as_float(w << 16); Vv[j * 128 + e8 + 2 * e + 1] = __uint_as_float(w & 0xffff0000u); } }
                __syncthreads();
                { const int dg = tid >> 5, eg = tid & 31; f32x4 a[4];
#pragma unroll
                  for (int r = 0; r < 4; ++r) a[r] = (f32x4){0.f, 0.f, 0.f, 0.f};
#pragma unroll 4
                  for (int j = 0; j < 64; ++j) { const f32x4 k4 = *(const LAS f32x4*)(Kt + j * 64 + dg * 4); const f32x4 v4 = *(const LAS f32x4*)(Vv + j * 128 + eg * 4);
#pragma unroll
                      for (int r = 0; r < 4; ++r) a[r] += v4 * k4[r]; }
                  GAS float* dst = (GAS float*)GLAS + (((size_t)(h * 128 + c)) * 64 + dg * 4) * 128 + eg * 4;
#pragma unroll
                  for (int r = 0; r < 4; ++r) *(GAS f32x4*)(dst + r * 128) = a[r]; }
            }
            __syncthreads();
        }
#endif
    }
    xcd_barrier(xbar);
#ifdef XTRA6
    xcd_barrier(xbar);
#endif
    {
        PHASE_IDS
#if NPH >= 2
        if (gtid < 32768) {
            const int h = gtid >> 13, rem = gtid & 8191, d = rem >> 7;
            float carry = 0.f; float* ptr = GLAS + (size_t)h * 128 * 8192 + rem; const float* dc = DEC + h * 128 * 64 + d;
            for (int c0 = 0; c0 < 128; c0 += 16) { float tmp[16], dd[16];
#pragma unroll
                for (int c = 0; c < 16; ++c) { tmp[c] = ((const GAS float*)ptr)[(size_t)(c0 + c) * 8192]; dd[c] = ((const GAS float*)dc)[(c0 + c) * 64]; }
#pragma unroll
                for (int c = 0; c < 16; ++c) { ((GAS float*)ptr)[(size_t)(c0 + c) * 8192] = carry; carry = carry * dd[c] + tmp[c]; } }
        }
#endif
#if NPH >= 4
        for (int it = blk; it < 256; it += nblk) {
            PHASE_IDS
            const int fr = lane & 15, fq = lane >> 4;
            const int g = it >> 7, t0 = (it & 127) * 64; const int tg = wv & 3, hp = wv >> 2; const int tok = t0 + tg * 16 + fr;
            bf16x8 qf[2][4]; f32x4 O[2][8]; float lrow[2]; const float negB = score_neg_bound(p.q_norm, p.k_norm);
#pragma unroll
            for (int q = 0; q < 2; ++q) load_qf(qf[q], QN + ((size_t)(g * 4 + hp * 2 + q) * S_ + tok) * 128, fq);
            int ntile = ((t0 + 32) >> 4) / 64 + 1; if (ntile > 8) ntile = 8;
            const bf16_t* Kb = KCMP + (size_t)g * 512 * 128; const bf16_t* Vt = VCMPT + (size_t)g * 128 * 512;
            attn_core<2, 2>(Kb, Vt, 512, qf, 0, ntile, [](int kt) { return kt + 1; }, [=](int, int key) { return 16 * key + 31 <= tok; }, [=](int kt) { return 1024 * kt + 1039 > t0; }, [](int) { return true; }, negB, O, lrow);
            float invl[2];
#pragma unroll
            for (int q = 0; q < 2; ++q) {
                float l = lrow[q]; l += __shfl_xor(l, 16); l += __shfl_xor(l, 32); invl[q] = 1.0f / fmaxf(l, 1e-30f);
                const int hl = hp * 2 + q; const float sc = ((const GAS float*)GATE)[tok * 24 + g * 12 + hl * 3 + 0] * invl[q];
#pragma unroll
                for (int db = 0; db < 8; ++db) { GAS float* op = (GAS float*)OCMP + (size_t)tok * 1024 + (g * 4 + hl) * 128 + db * 16 + fq * 4; *(GAS f32x4*)op = O[q][db] * sc; }
            }
            LAS float* imp = (LAS float*)(lds + A_IMP);
            for (int i = tid; i < 2 * 64 * 128; i += 512) imp[i] = 0.f;
            float prev_c3 = 0.f;
            const int wvs = __builtin_amdgcn_readfirstlane(wv);
            __syncthreads();
            attn_dma_k(Kb, 0, lds, wvs, lane);
            for (int kt = 0; kt < ntile; ++kt) {
                LAS unsigned char* kb = lds + (kt & 1) * ABUF;
                asm volatile("s_waitcnt vmcnt(0)" ::: "memory");
                __syncthreads();
                if (kt + 1 < ntile) attn_dma_k(Kb, kt + 1, lds + ((kt + 1) & 1) * ABUF, wvs, lane);
                f32x4 s[2][4]; attn_qk<2>(kb, qf, s, fr, fq, negB);
#pragma unroll
                for (int nb = 0; nb < 4; ++nb) {
                    float own = 0.f, c3 = 0.f;
#pragma unroll
                    for (int q = 0; q < 2; ++q) {
                        float pj[4];
#pragma unroll
                        for (int j = 0; j < 4; ++j) { const int key = kt * 64 + nb * 16 + fq * 4 + j; pj[j] = (16 * key + 31 <= tok) ? __builtin_amdgcn_exp2f(s[q][nb][j]) * invl[q] : 0.f; }
                        own += 2.f * (pj[0] + pj[1] + pj[2]) + pj[3]; c3 += pj[3];
                    }
                    const float a = __shfl(c3, (lane + 48) & 63), b = __shfl(prev_c3, (lane + 48) & 63);
                    const float val = own + (fq > 0 ? a : b);
                    prev_c3 = c3;
                    imp[(hp * 64 + tg * 16 + fr) * 128 + kt * 16 + nb * 4 + fq] = val;
                }
            }
            __syncthreads();
            LAS float* scl = (LAS float*)(lds + A_SCL) + wv * 128;
            for (int ti = 0; ti < 8; ++ti) {
                const int tl = wv * 8 + ti, tk = t0 + tl, cur = tk >> 6;
                float my[2]; bool caus[2];
#pragma unroll
                for (int hf = 0; hf < 2; ++hf) { const int m = lane + 64 * hf; caus[hf] = (m * 64 <= tk); const bool forced = (m == 0) | (m == cur) | (m == cur - 1);
                    my[hf] = caus[hf] ? (forced ? 1e4f : imp[tl * 128 + m] + imp[(64 + tl) * 128 + m]) : -1e4f; scl[m] = my[hf]; }
                asm volatile("s_waitcnt lgkmcnt(0)" ::: "memory");
                int rk0 = 0, rk1 = 0;
                for (int mm = 0; mm < 128; ++mm) { const float v = scl[mm]; rk0 += (v > my[0]) || (v == my[0] && mm < lane); rk1 += (v > my[1]) || (v == my[1] && mm < lane + 64); }
                const u64 b0 = __ballot(rk0 < 16 && caus[0]), b1 = __ballot(rk1 < 16 && caus[1]);
                if (lane == 0) *(u32x4*)(SEL + ((size_t)g * S_ + tk) * 4) = (u32x4){(unsigned)b0, (unsigned)(b0 >> 32), (unsigned)b1, (unsigned)(b1 >> 32)};
                asm volatile("s_waitcnt lgkmcnt(0)" ::: "memory");
            }
            __syncthreads();
        }
#endif
    }
    xcd_barrier(xbar);
    REPS(7) { if (rep_) xcd_barrier(xbar);
        PHASE_IDS
        if (rep_ && (DUPSUB & 8)) continue;
#if NPH >= 4
        for (int pi = blk; pi < 256; pi += nblk)
#pragma unroll 1
        for (int half = 0; half < 2; ++half) {
            PHASE_IDS
            const int fr = lane & 15, fq = lane >> 4;
            const int g = pi & 1, u = half ? (pi >> 1) : 255 - (pi >> 1), t0 = u * 32; const int tg = wv & 1, hl = wv >> 1; const int tl = tg * 16 + fr, tok = t0 + tl;
            LAS unsigned* bm = (LAS unsigned*)(lds + A_BM); LAS unsigned* un = (LAS unsigned*)(lds + A_UN);
            __syncthreads();
            if (tid < 4) un[tid] = 0u;
            __syncthreads();
            if (tid < 128) { const unsigned w = SEL[((size_t)g * S_ + t0 + (tid >> 2)) * 4 + (tid & 3)]; bm[tid] = w; atomicOr((unsigned*)&un[tid & 3], w); }
            __syncthreads();
            bf16x8 qf[1][4]; f32x4 O[1][8]; float lrow[1];
            load_qf(qf[0], QN + ((size_t)(g * 4 + hl) * S_ + tok) * 128, fq);
            const int end = (t0 >> 6) + 1;
            attn_core<1, 4>(KSN + (size_t)g * S_ * 128, VST + (size_t)g * 128 * S_, S_, qf, 0, end,
                      [=](int kt) { int n = kt + 1; while (n < end && !((un[n >> 5] >> (n & 31)) & 1u)) ++n; return n; },
                      [=](int, int key) { const int kt = key >> 6; return ((bm[tl * 4 + (kt >> 5)] >> (kt & 31)) & 1u) && key <= tok; },
                      [=](int kt) { return kt == end - 1; }, [=](int kt) { return ((bm[tl * 4 + (kt >> 5)] >> (kt & 31)) & 1u) != 0u; },
                      score_neg_bound(p.q_norm, p.k_norm + 128), O, lrow);
            {
                float l = lrow[0]; l += __shfl_xor(l, 16); l += __shfl_xor(l, 32);
                const float sc = ((const GAS float*)GATE)[tok * 24 + g * 12 + hl * 3 + 1] / fmaxf(l, 1e-30f);
#pragma unroll
                for (int db = 0; db < 8; ++db) { const size_t o = (size_t)tok * 1024 + (g * 4 + hl) * 128 + db * 16 + fq * 4; O[0][db] = *(const GAS f32x4*)((const GAS float*)ONSA + o) + *(const GAS f32x4*)((const GAS float*)OCMP + o) + O[0][db] * sc; }
#pragma unroll
                for (int db = 0; db < 8; ++db) { const f32x4 v = O[0][db];
                    u32x2 pk = {cvt_pk_bf16(v[0], v[1]), cvt_pk_bf16(v[2], v[3])}; *(GAS u32x2*)((GAS bf16_t*)MIX + (size_t)tok * LD2 + 512 + (g * 4 + hl) * 128 + db * 16 + fq * 4) = pk; }
            }
        }
#elif NPH == 3
        for (int i = gtid; i < S_ * 256; i += nthreads) { const int tok = i >> 8, c4 = (i & 255) * 4; const f32x4 v = *(const f32x4*)(ONSA + (size_t)tok * 1024 + c4);
            u32x2 pk = {cvt_pk_bf16(v[0], v[1]), cvt_pk_bf16(v[2], v[3])}; *(u32x2*)(MIX + (size_t)tok * LD2 + 512 + c4) = pk; }
#endif
#if NPH >= 2
        {
            PHASE_IDS
            LAS float* Bc = (LAS float*)lds; LAS float* Qt = Bc + 4096; LAS float* Kh = Qt + 4352; LAS float* Vv = Kh + 4352; LAS float* Ss = Vv + 8192; LAS float* Aa = Ss + 8192;
            for (int it = blk; it < 512; it += nblk) {
                const int h = it >> 7, c = it & 127, tk0 = c * 64;
                __syncthreads();
                for (int i = tid; i < 4096; i += 512) Bc[i] = ((const GAS float*)LA)[(size_t)(tk0 + (i >> 6)) * 256 + h * 64 + (i & 63)];
                u32x4 qraw, kraw, vraw[2]; f32x4 sraw[4];
                { const int j = tid >> 3, d8 = (tid & 7) * 8; qraw = *(const GAS u32x4*)((const GAS bf16_t*)PROJ + (size_t)(tk0 + j) * NPJ + PC_GQ + h * 64 + d8); kraw = *(const GAS u32x4*)((const GAS bf16_t*)PROJ + (size_t)(tk0 + j) * NPJ + PC_GK + h * 64 + d8); }
#pragma unroll
                for (int q = 0; q < 2; ++q) { const int cix = tid + q * 512, j = cix >> 4, e8 = (cix & 15) * 8; vraw[q] = *(const GAS u32x4*)((const GAS bf16_t*)PROJ + (size_t)(tk0 + j) * NPJ + PC_GV + h * 128 + e8); }
#pragma unroll
                for (int q = 0; q < 4; ++q) sraw[q] = *(const GAS f32x4*)((const GAS float*)GLAS + ((size_t)(h * 128 + c)) * 8192 + (tid + q * 512) * 4);
                __syncthreads();
                if (tid < 64) { float run = 0.f; for (int i = 0; i < 64; ++i) { run += Bc[i * 64 + tid]; Bc[i * 64 + tid] = run; } }
                __syncthreads();
                { const int j = tid >> 3, d8 = (tid & 7) * 8;
#pragma unroll
                  for (int e = 0; e < 4; ++e) { const int d = d8 + 2 * e; const float b0 = Bc[j * 64 + d], b1 = Bc[j * 64 + d + 1];
                      Qt[d * 68 + j] = __uint_as_float(qraw[e] << 16) * 0.125f * __expf(b0); Qt[(d + 1) * 68 + j] = __uint_as_float(qraw[e] & 0xffff0000u) * 0.125f * __expf(b1);
                      Kh[d * 68 + j] = __uint_as_float(kraw[e] << 16) * __expf(-b0); Kh[(d + 1) * 68 + j] = __uint_as_float(kraw[e] & 0xffff0000u) * __expf(-b1); } }
#pragma unroll
                for (int q = 0; q < 2; ++q) { const int cix = tid + q * 512, j = cix >> 4, e8 = (cix & 15) * 8;
#pragma unroll
                    for (int e = 0; e < 4; ++e) { const unsigned w = vraw[q][e]; Vv[j * 128 + e8 + 2 * e] = __uint_as_float(w << 16); Vv[j * 128 + e8 + 2 * e + 1] = __uint_as_float(w & 0xffff0000u); } }
#pragma unroll
                for (int q = 0; q < 4; ++q) *(LAS f32x4*)(Ss + (tid + q * 512) * 4) = sraw[q];
                __syncthreads();
                { const int i0 = (tid >> 5) * 4, j0 = (tid & 31) * 2; f32x4 a0 = (f32x4){0.f, 0.f, 0.f, 0.f}, a1 = a0;
                  if (j0 <= i0 + 3) {
#pragma unroll 4
                      for (int d = 0; d < 64; ++d) { const f32x4 q4 = *(const LAS f32x4*)(Qt + d * 68 + i0); const float k0v = Kh[d * 68 + j0], k1v = Kh[d * 68 + j0 + 1]; a0 += q4 * k0v; a1 += q4 * k1v; }
                  }
#pragma unroll
                  for (int r = 0; r < 4; ++r) { a0[r] = (j0 <= i0 + r) ? a0[r] : 0.f; a1[r] = (j0 + 1 <= i0 + r) ? a1[r] : 0.f; }
                  *(LAS f32x4*)(Aa + j0 * 68 + i0) = a0; *(LAS f32x4*)(Aa + (j0 + 1) * 68 + i0) = a1; }
                __syncthreads();
                { const int i0 = (tid >> 5) * 4, e0 = (tid & 31) * 4; f32x4 o[4];
#pragma unroll
                  for (int r = 0; r < 4; ++r) o[r] = (f32x4){0.f, 0.f, 0.f, 0.f};
#pragma unroll 4
                  for (int d = 0; d < 64; ++d) { const f32x4 q4 = *(const LAS f32x4*)(Qt + d * 68 + i0); const f32x4 s4 = *(const LAS f32x4*)(Ss + d * 128 + e0);
#pragma unroll
                      for (int r = 0; r < 4; ++r) o[r] += s4 * q4[r]; }
#pragma unroll 4
                  for (int j = 0; j < i0 + 4; ++j) { const f32x4 a4 = *(const LAS f32x4*)(Aa + j * 68 + i0); const f32x4 v4 = *(const LAS f32x4*)(Vv + j * 128 + e0);
#pragma unroll
                      for (int r = 0; r < 4; ++r) o[r] += v4 * a4[r]; }
                  const f32x4 gn = *(const GAS f32x4*)((const GAS float*)p.gla_onorm + e0);
                  u32x2 graw[4];
#pragma unroll
                  for (int r = 0; r < 4; ++r) graw[r] = *(const GAS u32x2*)((const GAS bf16_t*)PROJ + (size_t)(tk0 + i0 + r) * NPJ + PC_GR + h * 128 + e0);
#pragma unroll
                  for (int r = 0; r < 4; ++r) {
                      float ss = o[r][0] * o[r][0] + o[r][1] * o[r][1] + o[r][2] * o[r][2] + o[r][3] * o[r][3];
                      ss += __shfl_xor(ss, 1); ss += __shfl_xor(ss, 2); ss += __shfl_xor(ss, 4); ss += __shfl_xor(ss, 8); ss += __shfl_xor(ss, 16);
                      const float rr = rsqrtf(ss * (1.0f / 128.0f) + EPS_);
                      const float g0v = __uint_as_float(graw[r][0] << 16), g1v = __uint_as_float(graw[r][0] & 0xffff0000u), g2v = __uint_as_float(graw[r][1] << 16), g3v = __uint_as_float(graw[r][1] & 0xffff0000u);
                      u32x2 pk = {cvt_pk_bf16(o[r][0] * rr * gn[0] * silu_f(g0v), o[r][1] * rr * gn[1] * silu_f(g1v)), cvt_pk_bf16(o[r][2] * rr * gn[2] * silu_f(g2v), o[r][3] * rr * gn[3] * silu_f(g3v))};
                      *(GAS u32x2*)((GAS bf16_t*)MIX + (size_t)(tk0 + i0 + r) * LD2 + h * 128 + e0) = pk;
                  } }
            }
            __syncthreads();
        }
#endif
    }
    xcd_barrier(xbar);
    {
        PHASE_IDS
        pg8::Gemm g{MIX, WOUT, S_, 2048, 2048, LD2, LD2}; pg8::StaticOrder so; so.init(g.M, g.N, nblk, blk);
        EpiResid e{X1, X2, XB, SSQ2, 1.0f};
        pg8::gemm_phase(lds, g, so, e);
    }
    xcd_barrier(xbar);
    {
        PHASE_IDS
        pg8::Gemm g{XB, WFF, S_, 11264, 2048, LD2, LD2}; pg8::StaticOrder so; so.init(g.M, g.N, nblk, blk);
        EpiGateUp e{ACT, SSQ2};
        pg8::gemm_phase(lds, g, so, e);
    }
    xcd_barrier(xbar);
    {
        PHASE_IDS
        pg8::Gemm g{ACT, WD, S_, 2048, FF_, LDF, LDF}; pg8::StaticOrder so; so.init(g.M, g.N, nblk, blk);
        if (nblk == 256) { EpiFinal e{X2, p.out, SSQ3, (unsigned*)(wsp + OFF_PCNT), p.final_norm, 0.5f}; pg8::gemm_phase(lds, g, so, e); }
        else { EpiResid e{X2, X3, nullptr, SSQ3, 0.5f}; pg8::gemm_phase(lds, g, so, e); }
    }
    if (nblk != 256) {
    xcd_barrier(xbar);
    { PHASE_IDS
    for (int r = gwave; r < S_; r += nwaves) {
        const float rs = rstd_from(SSQ3, r); float* row = p.out + (size_t)r * D_;
        f32x4 vv[8], gg[8];
#pragma unroll
        for (int i = 0; i < 8; ++i) { const int c = (lane + 64 * i) * 4; vv[i] = *(const GAS f32x4*)((const GAS float*)row + c); gg[i] = *(const GAS f32x4*)((const GAS float*)p.final_norm + c); }
#pragma unroll
        for (int i = 0; i < 8; ++i) { const int c = (lane + 64 * i) * 4; *(GAS f32x4*)((GAS float*)row + c) = vv[i] * rs * gg[i]; }
    }
    }
    }
}

extern "C" void kernel_launch(void* const* d_in, const int* in_sizes, int n_in, void* d_out, int out_size, void* d_ws, size_t ws_size, hipStream_t stream) {
    static int grid_blocks = 0;
    if (grid_blocks == 0) {
        if (n_in != 30 || ws_size < WS_END) { fprintf(stderr, "kernel_launch: need 30 inputs and %zu bytes of workspace (got %d, %zu)\n", (size_t)WS_END, n_in, ws_size); grid_blocks = -1; return; }
        int dev = 0, cus = 0, per_cu = 0;
        hipGetDevice(&dev); hipDeviceGetAttribute(&cus, hipDeviceAttributeMultiprocessorCount, dev);
        if (hipFuncSetAttribute((const void*)mega, hipFuncAttributeMaxDynamicSharedMemorySize, LDS_BYTES) != hipSuccess) { fprintf(stderr, "hipFuncSetAttribute failed\n"); grid_blocks = -1; return; }
        if (hipOccupancyMaxActiveBlocksPerMultiprocessor(&per_cu, (const void*)mega, 512, LDS_BYTES) != hipSuccess || per_cu < 1) per_cu = 1;
        (void)hipGetLastError();
        grid_blocks = cus * per_cu;
    }
    if (grid_blocks < 0) return;
    Params p{};
    const float** fp = (const float**)&p;
    (void)fp;
    p.x = (const float*)d_in[0]; p.mem = (const float*)d_in[1]; p.pos = (const int*)d_in[2];
    p.ffn1_norm = (const float*)d_in[3]; p.ffn1_wg = (const float*)d_in[4]; p.ffn1_wu = (const float*)d_in[5]; p.ffn1_wd = (const float*)d_in[6];
    p.mix_norm = (const float*)d_in[7]; p.w_in = (const float*)d_in[8]; p.gla_wa = (const float*)d_in[9]; p.gla_ba = (const float*)d_in[10]; p.gla_onorm = (const float*)d_in[11];
    p.q_norm = (const float*)d_in[12]; p.k_norm = (const float*)d_in[13]; p.cmp_pos_k = (const float*)d_in[14]; p.cmp_w1_k = (const float*)d_in[15]; p.cmp_w2_k = (const float*)d_in[16];
    p.cmp_pos_v = (const float*)d_in[17]; p.cmp_w1_v = (const float*)d_in[18]; p.cmp_w2_v = (const float*)d_in[19]; p.mem_in_norm = (const float*)d_in[20]; p.w_mem_kv = (const float*)d_in[21];
    p.mem_q_norm = (const float*)d_in[22]; p.mem_k_norm = (const float*)d_in[23]; p.w_out = (const float*)d_in[24]; p.ffn2_norm = (const float*)d_in[25]; p.ffn2_wg = (const float*)d_in[26];
    p.ffn2_wu = (const float*)d_in[27]; p.ffn2_wd = (const float*)d_in[28]; p.final_norm = (const float*)d_in[29];
    p.out = (float*)d_out; p.ws = (unsigned char*)d_ws;
    if (hipMemsetAsync((unsigned char*)d_ws + OFF_BAR, 0, BAR_BYTES, stream) != hipSuccess) { fprintf(stderr, "memset of barrier words failed\n"); return; }
    void* args[] = {&p};
    hipError_t e = hipLaunchCooperativeKernel((const void*)mega, dim3(grid_blocks), dim3(512), args, LDS_BYTES, stream);
    if (e != hipSuccess) fprintf(stderr, "cooperative launch failed: %s (grid %d)\n", hipGetErrorString(e), grid_blocks);
}
```

```cpp
#include <hip/hip_runtime.h>
#include <hip/hip_cooperative_groups.h>
#include <cstdio>
namespace cg = cooperative_groups;

#ifndef NPH
#define NPH 4
#endif

#ifndef DUP
#define DUP 0
#endif
#ifndef DUPSUB
#define DUPSUB 7
#endif
#define REPS(k) for (int rep_ = 0; rep_ < (((DUP) >> (k)) & 1) + 1; ++rep_)

#define LAS __attribute__((address_space(3)))
#define GAS __attribute__((address_space(1)))
typedef unsigned short bf16_t;
typedef short bf16x8 __attribute__((ext_vector_type(8)));
typedef float f32x4 __attribute__((ext_vector_type(4)));
typedef unsigned u32x4 __attribute__((ext_vector_type(4)));
typedef unsigned u32x2 __attribute__((ext_vector_type(2)));
typedef unsigned long long u64;

constexpr int S_ = 8192, D_ = 2048, FF_ = 5632, NPJ = 4864, MEMLEN = 256;
constexpr int LD2 = 2048 + 64, LDF = 5632 + 64;
constexpr float EPS_ = 1e-6f;
constexpr int PC_GQ = 0, PC_GK = 256, PC_GV = 512, PC_GR = 1024, PC_NQ = 1536, PC_KC = 2560, PC_VC = 2816, PC_KS = 3072, PC_VS = 3328,
              PC_KW = 3584, PC_VW = 3840, PC_MQ = 4096, PC_GA = 4608, PC_NG = 4624;

constexpr size_t AL(size_t x) { return (x + 255) & ~(size_t)255; }
constexpr size_t OFF_WFF = 0;
constexpr size_t OFF_WD = OFF_WFF + (size_t)11264 * LD2 * 2;
constexpr size_t OFF_WIN = OFF_WD + (size_t)2048 * LDF * 2;
constexpr size_t OFF_WOUT = OFF_WIN + (size_t)NPJ * LD2 * 2;
constexpr size_t OFF_WMEM = OFF_WOUT + (size_t)2048 * LD2 * 2;
constexpr size_t OFF_WC1 = OFF_WMEM + (size_t)1024 * LD2 * 2;
constexpr size_t OFF_ACT = OFF_WC1 + (size_t)2 * 256 * 4096 * 2;
constexpr size_t OFF_XB = OFF_ACT + (size_t)S_ * LDF * 2;
constexpr size_t OFF_MIX = OFF_XB + (size_t)S_ * LD2 * 2;
constexpr size_t OFF_X2 = OFF_MIX + (size_t)S_ * LD2 * 2;
constexpr size_t OFF_QN = OFF_X2;
constexpr size_t OFF_KSN = OFF_QN + (size_t)8 * S_ * 128 * 2;
constexpr size_t OFF_KWN = OFF_KSN + (size_t)2 * S_ * 128 * 2;
constexpr size_t OFF_VST = OFF_KWN + (size_t)2 * S_ * 128 * 2;
constexpr size_t OFF_VWT = OFF_VST + (size_t)2 * S_ * 128 * 2;
constexpr size_t OFF_KCB = OFF_VWT + (size_t)2 * S_ * 128 * 2;
constexpr size_t OFF_VCB = OFF_KCB + (size_t)2 * S_ * 128 * 2 + 65536;
constexpr size_t OFF_MQN = OFF_VCB + (size_t)2 * S_ * 128 * 2 + 65536;
constexpr size_t OFF_LA = OFF_MQN + (size_t)4 * S_ * 128 * 2;
constexpr size_t OFF_GATE = OFF_LA + (size_t)S_ * 256 * 4;
constexpr size_t OFF_X2END = OFF_GATE + (size_t)S_ * 24 * 4;
static_assert(OFF_X2END <= OFF_X2 + (size_t)S_ * D_ * 4, "attention-stage buffers overflow the x2 region");
constexpr size_t OFF_ONSA = OFF_X2 + (size_t)S_ * D_ * 4;
constexpr size_t OFF_GLAS = OFF_ONSA + (size_t)S_ * 1024 * 4;
constexpr size_t OFF_ROPE = OFF_GLAS + (size_t)4 * 128 * 64 * 128 * 4;
constexpr size_t OFF_SSQ = OFF_ROPE + (size_t)2 * S_ * 64 * 4;
constexpr size_t OFF_SSQM = OFF_SSQ + (size_t)4 * S_ * 8;
constexpr size_t OFF_MEMB = OFF_SSQM + 256 * 8;
constexpr size_t OFF_KVMEM = OFF_MEMB + (size_t)256 * LD2 * 2;
constexpr size_t OFF_MEMK = OFF_KVMEM + (size_t)256 * 1024 * 4;
constexpr size_t OFF_MEMVT = OFF_MEMK + (size_t)4 * 256 * 128 * 2;
constexpr size_t OFF_HID = OFF_MEMVT + (size_t)4 * 256 * 128 * 2;
constexpr size_t OFF_C2 = OFF_HID + (size_t)4 * 512 * 256 * 4;
constexpr size_t OFF_KCMP = OFF_C2 + (size_t)4 * 512 * 128 * 4;
constexpr size_t OFF_VCMPT = OFF_KCMP + (size_t)2 * 512 * 128 * 2;
constexpr size_t OFF_SEL = OFF_VCMPT + (size_t)2 * 512 * 128 * 2;
constexpr size_t OFF_DEC = OFF_SEL + (size_t)2 * S_ * 4 * 4;
constexpr size_t OFF_CBIAS = OFF_DEC + (size_t)4 * 128 * 64 * 4;
constexpr size_t OFF_BAR = OFF_CBIAS + 2 * 256 * 128 + 4096;
constexpr size_t BAR_BYTES = 3456 * 4;
constexpr size_t OFF_PCNT = OFF_BAR + BAR_BYTES + 4096;
constexpr size_t WS_END = OFF_PCNT + 64 * 256 + 4096;

constexpr int LDS_MAIN = 147456;
constexpr int LDS_BYTES = LDS_MAIN + 64;
extern __shared__ __attribute__((aligned(16))) unsigned char smem_raw[];

struct Params {
    const float* x; const float* mem; const int* pos;
    const float* ffn1_norm; const float* ffn1_wg; const float* ffn1_wu; const float* ffn1_wd;
    const float* mix_norm; const float* w_in; const float* gla_wa; const float* gla_ba; const float* gla_onorm;
    const float* q_norm; const float* k_norm; const float* cmp_pos_k; const float* cmp_w1_k; const float* cmp_w2_k;
    const float* cmp_pos_v; const float* cmp_w1_v; const float* cmp_w2_v; const float* mem_in_norm; const float* w_mem_kv;
    const float* mem_q_norm; const float* mem_k_norm; const float* w_out; const float* ffn2_norm; const float* ffn2_wg;
    const float* ffn2_wu; const float* ffn2_wd; const float* final_norm;
    float* out; unsigned char* ws;
};

__device__ __forceinline__ unsigned cvt_pk_bf16(float lo, float hi) { unsigned r; asm("v_cvt_pk_bf16_f32 %0, %1, %2" : "=v"(r) : "v"(lo), "v"(hi)); return r; }
__device__ __forceinline__ float bf2f(bf16_t b) { return __uint_as_float(((unsigned)b) << 16); }
__device__ __forceinline__ bf16_t f2bf(float f) { unsigned u = __float_as_uint(f); u += 0x7FFFu + ((u >> 16) & 1u); return (bf16_t)(u >> 16); }
__device__ __forceinline__ float wave_sum(float v) {
#pragma unroll
    for (int o = 32; o >= 1; o >>= 1) v += __shfl_xor(v, o);
    return v;
}
__device__ __forceinline__ float sigmoid_f(float x) { return __builtin_amdgcn_rcpf(1.0f + __builtin_amdgcn_exp2f(-1.4426950408889634f * x)); }
__device__ __forceinline__ float silu_f(float x) { return x * sigmoid_f(x); }
__device__ __forceinline__ u64 ssq_fix(float s) { return (u64)(s * 16777216.0f + 0.5f); }
__device__ __forceinline__ float rstd_from(const u64* ssq, int row) { const float s = (float)((const GAS u64*)ssq)[row] * (1.0f / 16777216.0f); return rsqrtf(s * (1.0f / 2048.0f) + EPS_); }


#define XB_TMO      128
#define XB_XCNT(j)  (256  + 64 * (j))
#define XB_XSUB(j)  (1280 + 64 * (j))
#define XB_XGEN(j)  (2304 + 64 * (j))
#define XB_TOP      3328
#define XB_TOPGEN   3392
#define XCD_BAR_WORDS 3456
#define XB_SPIN_CAP (1u << 18)
__device__ __forceinline__ unsigned xb_ld(unsigned* p)              { return __hip_atomic_load(p, __ATOMIC_RELAXED, __HIP_MEMORY_SCOPE_AGENT); }
__device__ __forceinline__ unsigned xb_add(unsigned* p, unsigned v) { return __hip_atomic_fetch_add(p, v, __ATOMIC_RELAXED, __HIP_MEMORY_SCOPE_AGENT); }
__device__ __forceinline__ unsigned xb_xcc_id() { return (unsigned)__builtin_amdgcn_s_getreg((3 << 11) | 20) & 0xFu; }
#define XB_SPIN(cond, bar) do { unsigned _sp = 0; while (cond) { __builtin_amdgcn_s_sleep(1); \
    if ((++_sp & 255u) == 0u) { if (xb_ld(&(bar)[XB_TMO])) break; if (_sp > XB_SPIN_CAP) { atomicAdd(&(bar)[XB_TMO], 1u); break; } } } } while (0)
struct XcdBarrier { unsigned* bar; unsigned x; volatile LAS unsigned* st; };
__device__ __forceinline__ XcdBarrier xcd_barrier_post(unsigned* bar, volatile LAS unsigned* st) {
    XcdBarrier b; b.bar = bar; b.x = xb_xcc_id(); b.st = st;
    if (threadIdx.x == 0) st[2] = xb_add(&bar[XB_XCNT(b.x)], 1u);
    return b;
}
__device__ __forceinline__ void xcd_barrier_complete(unsigned* bar, unsigned x, unsigned& nloc, unsigned& nx) {
    const unsigned G = gridDim.x * gridDim.y * gridDim.z;
    unsigned sum, cnt, mine, sp = 0u;
    for (;;) {
        sum = 0u; cnt = 0u; mine = 0u;
#pragma unroll
        for (unsigned j = 0; j < 16; ++j) { const unsigned c = xb_ld(&bar[XB_XCNT(j)]); sum += c; cnt += (c > 0u) ? 1u : 0u; mine = (j == x) ? c : mine; }
        if (sum == G) break;
        __builtin_amdgcn_s_sleep(1);
        if ((++sp & 255u) == 0u) { if (xb_ld(&bar[XB_TMO])) break; if (sp > XB_SPIN_CAP) { atomicAdd(&bar[XB_TMO], 1u); break; } }
    }
    nloc = mine > 0u ? mine : 1u; nx = cnt > 0u ? cnt : 1u;
}
__device__ __forceinline__ void xcd_barrier(const XcdBarrier& b) {
    asm volatile("s_waitcnt vmcnt(0)" ::: "memory");
    __syncthreads();
    if (threadIdx.x == 0) {
        unsigned* bar = b.bar;
        __builtin_amdgcn_s_waitcnt(0);
        unsigned nloc = b.st[0], nx = b.st[1];
        if (nloc == 0u) { xcd_barrier_complete(bar, b.x, nloc, nx); b.st[0] = nloc; b.st[1] = nx; }
        const unsigned old = xb_add(&bar[XB_XSUB(b.x)], 1u);
        const unsigned gen = old / nloc;
        if (old + 1u == (gen + 1u) * nloc) {
            __builtin_amdgcn_fence(__ATOMIC_RELEASE, "agent");
            asm volatile("s_waitcnt vmcnt(0)" ::: "memory");
            const unsigned og = xb_add(&bar[XB_TOP], 1u);
            const unsigned tg = og / nx;
            if (og + 1u == (tg + 1u) * nx) xb_add(&bar[XB_TOPGEN], 1u);
            else XB_SPIN(xb_ld(&bar[XB_TOPGEN]) == tg, bar);
            __builtin_amdgcn_fence(__ATOMIC_ACQUIRE, "agent");
            xb_add(&bar[XB_XGEN(b.x)], 1u);
            asm volatile("s_waitcnt vmcnt(0)" ::: "memory");
        } else {
            XB_SPIN(xb_ld(&bar[XB_XGEN(b.x)]) == gen, bar);
            __builtin_amdgcn_fence(__ATOMIC_ACQUIRE, "agent");
            asm volatile("s_waitcnt vmcnt(0)" ::: "memory");
        }
    }
    __syncthreads();
}

namespace pg8 {
constexpr int BM = 256, BK = 64, HALF = 128, HTB = HALF * BK * 2, STAGE_BYTES = 8 * HTB, NXCD = 8, WGM = 8;
__device__ __forceinline__ int lds_byte(int r, int c) { const int st = (r >> 4) * 2 + (c >> 5), rr = r & 15, cc = c & 31, ob = rr * 64 + cc * 2; return st * 1024 + (ob ^ (((ob >> 9) & 1) << 5)); }
__device__ __forceinline__ void stage_rc(int b, int& R, int& C) { const int st = b / 1024, sb = b % 1024, swz = sb ^ (((sb >> 9) & 1) << 5); R = (st >> 1) * 16 + swz / 64; C = (st & 1) * 32 + (swz % 64) / 2; }
__device__ __forceinline__ int perm32(int rho) { const int n = rho >> 4, i = rho & 15; return 8 * (i >> 2) + 4 * n + (i & 3); }
struct Unit { int pm, pn; };
struct Gemm { const bf16_t* A; const bf16_t* Bt; int M, N, K, lda, ldb; };
struct StaticOrder {
    int nM, nN, nwg, G, c;
    __device__ void init(int M, int N, int G_, int c_) { nM = M / BM; nN = N / BM; nwg = nM * nN; G = G_; c = c_; }
    __device__ bool next(int i, Unit& u) const {
        const long L = (long)i * G + c; if (L >= nwg) return false;
        int wgid = (int)L; { const int q = nwg / NXCD, r = nwg % NXCD, xcd = wgid % NXCD, off = wgid / NXCD; wgid = (xcd < r ? xcd * (q + 1) : r * (q + 1) + (xcd - r) * q) + off; }
        const int nig = WGM * nN, gid = wgid / nig, fm = gid * WGM, gsz = (nM - fm) < WGM ? (nM - fm) : WGM;
        u.pm = fm + ((wgid % nig) % gsz); u.pn = (wgid % nig) / gsz; return true;
    }
};

template <class Epi, class Sched>
__device__ __forceinline__ void gemm_phase(LAS unsigned char* lds, const Gemm g, const Sched& S, const Epi& E) {
    int tid = threadIdx.x; asm volatile("" : "+v"(tid));
    const int wid = __builtin_amdgcn_readfirstlane(tid >> 6), lane = tid & 63, wr = wid >> 2, wc = wid & 3, fr = lane & 15, fq = lane >> 4;
    const int K = g.K, nt = K / BK;
    unsigned voffA[2], voffB[2];
#pragma unroll
    for (int i = 0; i < 2; ++i) { int R, C; stage_rc(tid * 16 + i * 8192, R, C); const int Rb = Epi::PERM ? ((R & ~31) + perm32(R & 31)) : R;
        voffA[i] = (unsigned)(R * g.lda + C) * 2u; voffB[i] = (unsigned)(Rb * g.ldb + C) * 2u; }
    const size_t kstep = (size_t)(BK * 2);
    const size_t hstepA = (size_t)HALF * g.lda * 2, hstepB = (size_t)HALF * g.ldb * 2;
    const size_t tstepA = 2 * hstepA, tstepB = 2 * hstepB;
    const unsigned ldsw = (unsigned)wid * 1024u;
    const int aoff = lds_byte(wr * 64 + fr, fq * 8), boff = lds_byte(wc * 32 + fr, fq * 8);
#define PG8_SA(b, h) (((b) * 2 + (h)) * HTB)
#define PG8_SB(b, h) ((4 + (b) * 2 + (h)) * HTB)
#define PG8_STAGE(bufoff, gbase, voff) do { _Pragma("unroll") for (int _i = 0; _i < 2; ++_i) \
        __builtin_amdgcn_global_load_lds((const unsigned*)((const char*)(gbase) + (voff)[_i]), (LAS unsigned*)(lds + (bufoff) + ldsw + _i * 8192), 16, 0, 0); } while (0)
#define PG8_LDA(dst, b, h) do { _Pragma("unroll") for (int m = 0; m < 4; ++m) _Pragma("unroll") for (int k = 0; k < 2; ++k) dst[m][k] = *(const LAS bf16x8*)(lds + PG8_SA(b, h) + aoff + m * 2048 + k * 1024); } while (0)
#define PG8_LDB(dst, b, h) do { _Pragma("unroll") for (int n = 0; n < 2; ++n) _Pragma("unroll") for (int k = 0; k < 2; ++k) dst[n][k] = *(const LAS bf16x8*)(lds + PG8_SB(b, h) + boff + n * 2048 + k * 1024); } while (0)
#define PG8_MMA(ai, bj, At, Bt) do { __builtin_amdgcn_s_setprio(1); _Pragma("unroll") for (int m = 0; m < 4; ++m) _Pragma("unroll") for (int n = 0; n < 2; ++n) _Pragma("unroll") for (int k = 0; k < 2; ++k) \
        acc[ai][bj][m][n] = __builtin_amdgcn_mfma_f32_16x16x32_bf16(Bt[n][k], At[m][k], acc[ai][bj][m][n], 0, 0, 0); __builtin_amdgcn_s_setprio(0); } while (0)
#define PG8_WAIT_V(n) asm volatile("s_waitcnt vmcnt(" #n ")" ::: "memory")
#define PG8_WAIT_L(n) asm volatile("s_waitcnt lgkmcnt(" #n ")" ::: "memory")
#define PG8_BAR __builtin_amdgcn_s_barrier()
#define PG8_SCHED __builtin_amdgcn_sched_barrier(0)
    Unit cur, nxt; int ui = 0;
    if (!S.next(0, cur)) return;
    f32x4 acc[2][2][4][2];
#pragma unroll
    for (int a = 0; a < 2; ++a)
#pragma unroll
        for (int b = 0; b < 2; ++b)
#pragma unroll
            for (int m = 0; m < 4; ++m)
#pragma unroll
                for (int n = 0; n < 2; ++n) acc[a][b][m][n] = (f32x4){0.f, 0.f, 0.f, 0.f};
    bf16x8 At[4][2], B0[2][2], B1[2][2];
    const char* cA = (const char*)g.A + (size_t)cur.pm * tstepA; const char* cB = (const char*)g.Bt + (size_t)cur.pn * tstepB;
    PG8_STAGE(PG8_SB(0, 0), cB, voffB); PG8_STAGE(PG8_SA(0, 0), cA, voffA); PG8_STAGE(PG8_SB(0, 1), cB + hstepB, voffB); PG8_STAGE(PG8_SA(0, 1), cA + hstepA, voffA);
    if (wr == 1) PG8_BAR;
    PG8_WAIT_V(4); PG8_BAR;
    PG8_STAGE(PG8_SB(1, 0), cB + kstep, voffB); PG8_STAGE(PG8_SA(1, 0), cA + kstep, voffA); PG8_STAGE(PG8_SB(1, 1), cB + hstepB + kstep, voffB);
    PG8_WAIT_V(6); PG8_BAR;
    for (;;) {
        const bool has_next = S.next(ui + 1, nxt);
        const char* nA = has_next ? (const char*)g.A + (size_t)nxt.pm * tstepA : cA; const char* nB = has_next ? (const char*)g.Bt + (size_t)nxt.pn * tstepB : cB;
        for (int t = 0; t < nt; t += 2) {
            const bool last = (t == nt - 2);
            const char* a1 = cA + (size_t)(t + 1) * kstep;
            const char* a2 = last ? nA : cA + (size_t)(t + 2) * kstep; const char* b2 = last ? nB : cB + (size_t)(t + 2) * kstep;
            const char* a3 = a2 + kstep; const char* b3 = b2 + kstep;
            PG8_LDB(B0, 0, 0); PG8_SCHED; PG8_LDA(At, 0, 0); PG8_STAGE(PG8_SA(1, 1), a1 + hstepA, voffA);
            PG8_WAIT_L(8); PG8_BAR; PG8_WAIT_L(0); PG8_MMA(0, 0, At, B0); PG8_BAR; PG8_SCHED;
            PG8_LDB(B1, 0, 1); PG8_STAGE(PG8_SB(0, 0), b2, voffB);
            PG8_BAR; PG8_WAIT_L(0); PG8_MMA(0, 1, At, B1); PG8_BAR;
            PG8_LDA(At, 0, 1); PG8_STAGE(PG8_SA(0, 0), a2, voffA);
            PG8_BAR; PG8_WAIT_L(0); PG8_MMA(1, 0, At, B0); PG8_BAR; PG8_SCHED;
            PG8_STAGE(PG8_SB(0, 1), b2 + hstepB, voffB);
            PG8_WAIT_V(6); PG8_BAR; PG8_MMA(1, 1, At, B1); PG8_BAR;
            PG8_LDB(B0, 1, 0); PG8_SCHED; PG8_LDA(At, 1, 0); PG8_STAGE(PG8_SA(0, 1), a2 + hstepA, voffA);
            PG8_WAIT_L(8); PG8_BAR; PG8_WAIT_L(0); PG8_MMA(0, 0, At, B0); PG8_BAR; PG8_SCHED;
            PG8_LDB(B1, 1, 1); PG8_STAGE(PG8_SB(1, 0), b3, voffB);
            PG8_BAR; PG8_WAIT_L(0); PG8_MMA(0, 1, At, B1); PG8_BAR;
            PG8_LDA(At, 1, 1); PG8_STAGE(PG8_SA(1, 0), a3, voffA);
            PG8_BAR; PG8_WAIT_L(0); PG8_MMA(1, 0, At, B0); PG8_BAR; PG8_SCHED;
            PG8_STAGE(PG8_SB(1, 1), b3 + hstepB, voffB);
            PG8_WAIT_V(6); PG8_BAR; PG8_MMA(1, 1, At, B1); PG8_BAR;
        }
        E(acc, cur, wr, wc, fr, fq);
        if (!has_next) break;
#pragma unroll
        for (int a = 0; a < 2; ++a)
#pragma unroll
            for (int b = 0; b < 2; ++b)
#pragma unroll
                for (int m = 0; m < 4; ++m)
#pragma unroll
                    for (int n = 0; n < 2; ++n) acc[a][b][m][n] = (f32x4){0.f, 0.f, 0.f, 0.f};
        cur = nxt; cA = nA; cB = nB; ++ui;
    }
    PG8_WAIT_V(0);
    if (wr == 0) PG8_BAR;
    PG8_BAR;
#undef PG8_SA
#undef PG8_SB
#undef PG8_STAGE
#undef PG8_LDA
#undef PG8_LDB
#undef PG8_MMA
#undef PG8_WAIT_V
#undef PG8_WAIT_L
#undef PG8_BAR
#undef PG8_SCHED
}
}
using pg8::Unit; using pg8::HALF; using pg8::BM;

struct EpiGateUp {
    static constexpr bool PERM = true;
    bf16_t* act; const u64* ssq;
    __device__ __forceinline__ void operator()(const f32x4 (&acc)[2][2][4][2], const Unit& u, int wr, int wc, int fr, int fq) const {
        const int row0 = u.pm * BM + wr * 64 + fr, col0 = u.pn * 128 + wc * 32 + 8 * fq;
        float rsv[2][4];
#pragma unroll
        for (int ai = 0; ai < 2; ++ai)
#pragma unroll
            for (int m = 0; m < 4; ++m) rsv[ai][m] = rstd_from(ssq, row0 + ai * HALF + m * 16);
#pragma unroll
        for (int ai = 0; ai < 2; ++ai)
#pragma unroll
            for (int m = 0; m < 4; ++m) {
                const int r = row0 + ai * HALF + m * 16; const float rs = rsv[ai][m];
                float o[8];
#pragma unroll
                for (int n = 0; n < 2; ++n)
#pragma unroll
                    for (int j = 0; j < 4; ++j) { const float gv = acc[ai][0][m][n][j] * rs, uv = acc[ai][1][m][n][j] * rs; o[n * 4 + j] = silu_f(gv) * uv; }
                u32x4 pk = {cvt_pk_bf16(o[0], o[1]), cvt_pk_bf16(o[2], o[3]), cvt_pk_bf16(o[4], o[5]), cvt_pk_bf16(o[6], o[7])};
                *(GAS u32x4*)((GAS bf16_t*)act + (size_t)r * LDF + col0) = pk;
            }
    }
};
struct EpiScaleBf16 {
    static constexpr bool PERM = true;
    bf16_t* O; int ldc; const u64* ssq;
    __device__ __forceinline__ void operator()(const f32x4 (&acc)[2][2][4][2], const Unit& u, int wr, int wc, int fr, int fq) const {
        const int row0 = u.pm * BM + wr * 64 + fr, col0 = u.pn * BM + wc * 32 + 8 * fq;
        float rsv[2][4];
#pragma unroll
        for (int ai = 0; ai < 2; ++ai)
#pragma unroll
            for (int m = 0; m < 4; ++m) rsv[ai][m] = rstd_from(ssq, row0 + ai * HALF + m * 16);
#pragma unroll
        for (int ai = 0; ai < 2; ++ai)
#pragma unroll
            for (int m = 0; m < 4; ++m) {
                const int r = row0 + ai * HALF + m * 16; const float rs = rsv[ai][m];
#pragma unroll
                for (int bj = 0; bj < 2; ++bj) {
                    const f32x4 v0 = acc[ai][bj][m][0] * rs, v1 = acc[ai][bj][m][1] * rs;
                    u32x4 pk = {cvt_pk_bf16(v0[0], v0[1]), cvt_pk_bf16(v0[2], v0[3]), cvt_pk_bf16(v1[0], v1[1]), cvt_pk_bf16(v1[2], v1[3])};
                    *(GAS u32x4*)((GAS bf16_t*)O + (size_t)r * ldc + col0 + bj * HALF) = pk;
                }
            }
    }
};
struct EpiResid {
    static constexpr bool PERM = false;
    const float* resid; float* xo; bf16_t* xb; u64* ssq; float alpha;
    __device__ __forceinline__ void operator()(const f32x4 (&acc)[2][2][4][2], const Unit& u, int wr, int wc, int fr, int fq) const {
        const int row0 = u.pm * BM + wr * 64 + fr, col0 = u.pn * BM + wc * 32 + 4 * fq;
        const GAS float* rsd = (const GAS float*)resid; GAS float* xog = (GAS float*)xo; GAS bf16_t* xbg = (GAS bf16_t*)xb;
        f32x4 rv[2][4];
#pragma unroll
        for (int q = 0; q < 4; ++q) rv[0][q] = *(const GAS f32x4*)(rsd + (size_t)row0 * D_ + col0 + (q >> 1) * HALF + (q & 1) * 16);
#pragma unroll
        for (int gi = 0; gi < 8; ++gi) {
            const int ai = gi >> 2, m = gi & 3, r = row0 + ai * HALF + m * 16;
            if (gi < 7) { const int rn = row0 + ((gi + 1) >> 2) * HALF + ((gi + 1) & 3) * 16;
#pragma unroll
                for (int q = 0; q < 4; ++q) rv[(gi + 1) & 1][q] = *(const GAS f32x4*)(rsd + (size_t)rn * D_ + col0 + (q >> 1) * HALF + (q & 1) * 16); }
            float ss = 0.f;
#pragma unroll
            for (int bj = 0; bj < 2; ++bj)
#pragma unroll
                for (int n = 0; n < 2; ++n) {
                    const size_t o = (size_t)r * D_ + col0 + bj * HALF + n * 16;
                    const f32x4 v = rv[gi & 1][bj * 2 + n] + acc[ai][bj][m][n] * alpha;
                    *(GAS f32x4*)(xog + o) = v;
                    ss += v[0] * v[0] + v[1] * v[1] + v[2] * v[2] + v[3] * v[3];
                    if (xb) { u32x2 pk = {cvt_pk_bf16(v[0], v[1]), cvt_pk_bf16(v[2], v[3])}; *(GAS u32x2*)(xbg + (size_t)r * LD2 + col0 + bj * HALF + n * 16) = pk; }
                }
            ss += __shfl_xor(ss, 16); ss += __shfl_xor(ss, 32);
            if (fq == 0) atomicAdd((unsigned long long*)(ssq + r), (unsigned long long)ssq_fix(ss));
        }
    }
};
struct EpiFinal {
    static constexpr bool PERM = false;
    const float* resid; float* y; u64* ssq; unsigned* cnt; const float* gain; float alpha;
    __device__ __forceinline__ void operator()(const f32x4 (&acc)[2][2][4][2], const Unit& u, int wr, int wc, int fr, int fq) const {
        const int row0 = u.pm * BM + wr * 64 + fr, col0 = u.pn * BM + wc * 32 + 4 * fq;
        const GAS float* rsd = (const GAS float*)resid; GAS float* yg = (GAS float*)y;
        f32x4 v[8][4];
#pragma unroll
        for (int ai = 0; ai < 2; ++ai) {
            f32x4 rv[4][4];
#pragma unroll
            for (int m = 0; m < 4; ++m)
#pragma unroll
                for (int q = 0; q < 4; ++q) rv[m][q] = *(const GAS f32x4*)(rsd + (size_t)(row0 + ai * HALF + m * 16) * D_ + col0 + (q >> 1) * HALF + (q & 1) * 16);
#pragma unroll
            for (int m = 0; m < 4; ++m) {
                const int r = row0 + ai * HALF + m * 16; float ss = 0.f;
#pragma unroll
                for (int q = 0; q < 4; ++q) { const f32x4 t = rv[m][q] + acc[ai][q >> 1][m][q & 1] * alpha; v[ai * 4 + m][q] = t; ss += t[0] * t[0] + t[1] * t[1] + t[2] * t[2] + t[3] * t[3]; }
                ss += __shfl_xor(ss, 16); ss += __shfl_xor(ss, 32);
                if (fq == 0) atomicAdd((unsigned long long*)(ssq + r), (unsigned long long)ssq_fix(ss));
            }
        }
        asm volatile("s_waitcnt vmcnt(0)" ::: "memory");
        unsigned* c = cnt + (u.pm * 2 + wr) * 64;
        if (fr == 0 && fq == 0) (void)__hip_atomic_fetch_add(c, 1u, __ATOMIC_RELAXED, __HIP_MEMORY_SCOPE_AGENT);
        for (unsigned spins = 0; (unsigned)__builtin_amdgcn_readfirstlane(__hip_atomic_load(c, __ATOMIC_RELAXED, __HIP_MEMORY_SCOPE_AGENT)) < 32u; ) {
            __builtin_amdgcn_s_sleep(1); if (++spins > (1u << 16)) break;
        }
        f32x4 gn[4];
#pragma unroll
        for (int q = 0; q < 4; ++q) gn[q] = *(const GAS f32x4*)((const GAS float*)gain + col0 + (q >> 1) * HALF + (q & 1) * 16);
        float rs[8];
#pragma unroll
        for (int gi = 0; gi < 8; ++gi) { const int r = row0 + (gi >> 2) * HALF + (gi & 3) * 16;
            const u64 sv = __hip_atomic_load((unsigned long long*)(ssq + r), __ATOMIC_RELAXED, __HIP_MEMORY_SCOPE_AGENT);
            rs[gi] = rsqrtf((float)sv * (1.0f / 16777216.0f) * (1.0f / 2048.0f) + EPS_); }
#pragma unroll
        for (int gi = 0; gi < 8; ++gi) { const int r = row0 + (gi >> 2) * HALF + (gi & 3) * 16;
#pragma unroll
            for (int q = 0; q < 4; ++q) *(GAS f32x4*)(yg + (size_t)r * D_ + col0 + (q >> 1) * HALF + (q & 1) * 16) = v[gi][q] * rs[gi] * gn[q]; }
    }
};
struct EpiMemKV {
    static constexpr bool PERM = false;
    float* O; const u64* ssq;
    __device__ __forceinline__ void operator()(const f32x4 (&acc)[2][2][4][2], const Unit& u, int wr, int wc, int fr, int fq) const {
        const int row0 = u.pm * BM + wr * 64 + fr, col0 = u.pn * BM + wc * 32 + 4 * fq;
#pragma unroll
        for (int ai = 0; ai < 2; ++ai)
#pragma unroll
            for (int m = 0; m < 4; ++m) {
                const int r = row0 + ai * HALF + m * 16; const float rs = rstd_from(ssq, r);
#pragma unroll
                for (int bj = 0; bj < 2; ++bj)
#pragma unroll
                    for (int n = 0; n < 2; ++n) *(f32x4*)(O + (size_t)r * 1024 + col0 + bj * HALF + n * 16) = acc[ai][bj][m][n] * rs;
            }
    }
};
struct EpiCmp1 {
    static constexpr bool PERM = false;
    float* O; const float* bias;
    __device__ __forceinline__ void operator()(const f32x4 (&acc)[2][2][4][2], const Unit& u, int wr, int wc, int fr, int fq) const {
        const int row0 = u.pm * BM + wr * 64 + fr, col0 = wc * 32 + 4 * fq;
#pragma unroll
        for (int ai = 0; ai < 2; ++ai)
#pragma unroll
            for (int m = 0; m < 4; ++m) {
                const int r = row0 + ai * HALF + m * 16;
#pragma unroll
                for (int bj = 0; bj < 2; ++bj)
#pragma unroll
                    for (int n = 0; n < 2; ++n) {
                        const int c = col0 + bj * HALF + n * 16; const f32x4 b = *(const f32x4*)(bias + c); f32x4 v = acc[ai][bj][m][n] + b;
                        v[0] = silu_f(v[0]); v[1] = silu_f(v[1]); v[2] = silu_f(v[2]); v[3] = silu_f(v[3]);
                        *(f32x4*)(O + (size_t)r * 256 + c) = v;
                    }
            }
    }
};

template <class SrcF>
__device__ __forceinline__ void transpose_convert(SrcF srcf, const float* gain, bf16_t* dst, int K, int N, int ldd, int blk, int nblk) {
    LAS float* tile = (LAS float*)smem_raw;
    int t = threadIdx.x; asm volatile("" : "+v"(t));
    const int tilesK = K / 64, total = tilesK * (N / 128);
    const float* anyvalid = srcf(0, 0);
    f32x4 va[4], vb[4]; float ga[4], gb[4];
    const GAS float* gsrc = (const GAS float*)(gain ? gain : anyvalid);
    auto load_tile = [&](int it, f32x4 (&v)[4], float (&g)[4]) {
        const int tk = it % tilesK, tn = it / tilesK, k0 = tk * 64, n0 = tn * 128;
#pragma unroll
        for (int i = 0; i < 4; ++i) { const int idx = t + i * 512, k = idx >> 5, c4 = (idx & 31) * 4; const float* sp = srcf(k0 + k, n0 + c4);
            sp = sp ? sp : anyvalid;
            v[i] = __builtin_nontemporal_load((const GAS f32x4*)sp);
            g[i] = gsrc[k0 + k]; }
    };
    auto emit = [&](int it, const f32x4 (&v)[4], const float (&g)[4], LAS float* tl) {
        const int tk = it % tilesK, tn = it / tilesK, k0 = tk * 64, n0 = tn * 128;
#pragma unroll
        for (int i = 0; i < 4; ++i) { const int idx = t + i * 512, k = idx >> 5, c4 = (idx & 31) * 4;
            const float sc = (srcf(k0 + k, n0 + c4) == nullptr) ? 0.f : (gain ? g[i] : 1.f);
#pragma unroll
            for (int e = 0; e < 4; ++e) tl[(c4 + e) * 65 + k] = v[i][e] * sc; }
        __syncthreads();
        const int n = t >> 2, k16 = (t & 3) * 16; const LAS float* tp = tl + n * 65 + k16;
        u32x4 p0 = {cvt_pk_bf16(tp[0], tp[1]), cvt_pk_bf16(tp[2], tp[3]), cvt_pk_bf16(tp[4], tp[5]), cvt_pk_bf16(tp[6], tp[7])};
        u32x4 p1 = {cvt_pk_bf16(tp[8], tp[9]), cvt_pk_bf16(tp[10], tp[11]), cvt_pk_bf16(tp[12], tp[13]), cvt_pk_bf16(tp[14], tp[15])};
        GAS bf16_t* dp = (GAS bf16_t*)dst + (size_t)(n0 + n) * ldd + k0 + k16;
        *(GAS u32x4*)dp = p0; *(GAS u32x4*)(dp + 8) = p1;
    };
    int it = blk;
    if (it < total) load_tile(it, va, ga);
    if (it + nblk < total) load_tile(it + nblk, vb, gb);
    __syncthreads();
    for (; it < total; it += 2 * nblk) {
        emit(it, va, ga, tile);
        if (it + 2 * nblk < total) load_tile(it + 2 * nblk, va, ga);
        if (it + nblk < total) {
            emit(it + nblk, vb, gb, tile + 128 * 65);
            if (it + 3 * nblk < total) load_tile(it + 3 * nblk, vb, gb);
        }
    }
    __syncthreads();
}
__device__ __forceinline__ int win_src_col(int n) {
    if (n < 1536) return n;
    if (n < 4096) return n + 16;
    if (n < 4608) return n + 40;
    if (n < 4624) return n - 4608 + 1536;
    if (n < 4648) return n - 4624 + 4112;
    return -1;
}
__device__ void convert_ffn_weights(const float* wg, const float* wu, const float* wd, const float* gain, unsigned char* ws, int blk, int nblk) {
    transpose_convert([=](int k, int n) { const int p = n >> 8, half = (n >> 7) & 1, j = n & 127; const float* s = half ? wu : wg; return s + ((size_t)k * FF_ + p * 128 + j); },
                      gain, (bf16_t*)(ws + OFF_WFF), 2048, 11264, LD2, blk, nblk);
    transpose_convert([=](int k, int n) { return wd + ((size_t)k * D_ + n); }, nullptr, (bf16_t*)(ws + OFF_WD), FF_, 2048, LDF, blk, nblk);
}

constexpr int KT_BYTES = 64 * 256, VT_BYTES = 128 * 128, ABUF = KT_BYTES + VT_BYTES;
constexpr int A_IMP = 2 * ABUF;
constexpr int A_SCL = A_IMP + 65536;
constexpr int A_BM = A_SCL + 4096;
constexpr int A_UN = A_BM + 1024;
static_assert(A_UN + 64 <= LDS_BYTES, "LDS");
__host__ __device__ constexpr int vperm(int k) { return 8 * (4 * (k >> 5) + ((k >> 2) & 3)) + 4 * ((k >> 4) & 1) + (k & 3); }
__host__ __device__ constexpr int vperm_inv(int n) { return 32 * (n >> 5) + 16 * ((n >> 2) & 1) + 4 * ((n >> 3) & 3) + (n & 3); }
constexpr float SM_SCALE = 0.08838834764831845f;
constexpr float QSCALE = 0.08838834764831845f * 1.4426950408889634f;

__device__ __forceinline__ void attn_dma_k(const bf16_t* Kb, int tile, LAS unsigned char* buf, int wv, int lane) {
#pragma unroll
    for (int i = 0; i < 2; ++i) {
        const int row = (i * 8 + wv) * 4 + (lane >> 4), ch = (lane & 15) ^ (row & 15);
        __builtin_amdgcn_global_load_lds((const unsigned*)(Kb + ((size_t)(tile * 64 + row) * 128 + ch * 8)), (LAS unsigned*)(buf + (i * 8 + wv) * 1024), 16, 0, 0);
    }
}
__device__ __forceinline__ void attn_dma_v(const bf16_t* Vt, int ldv, int tile, LAS unsigned char* buf, int wv, int lane) {
#pragma unroll
    for (int i = 0; i < 2; ++i) {
        const int row = (i * 8 + wv) * 8 + (lane >> 3), ch = (lane & 7) ^ ((row >> 1) & 7);
        __builtin_amdgcn_global_load_lds((const unsigned*)(Vt + ((size_t)row * ldv + tile * 64 + ch * 8)), (LAS unsigned*)(buf + KT_BYTES + (i * 8 + wv) * 1024), 16, 0, 0);
    }
}
template <int NG>
__device__ __forceinline__ void attn_qk(LAS unsigned char* kbuf, const bf16x8 (&qf)[NG][4], f32x4 (&s)[NG][4], int fr, int fq, float negB) {
#pragma unroll
    for (int g = 0; g < NG; ++g)
#pragma unroll
        for (int nb = 0; nb < 4; ++nb) s[g][nb] = (f32x4){negB, negB, negB, negB};
    bf16x8 kf[2][4];
#pragma unroll
    for (int kk = 0; kk < 4; ++kk) kf[0][kk] = *(const LAS bf16x8*)(kbuf + fr * 256 + (((kk * 4 + fq) ^ fr) << 4));
#pragma unroll
    for (int nb = 0; nb < 4; ++nb) {
        if (nb < 3) {
#pragma unroll
            for (int kk = 0; kk < 4; ++kk) kf[(nb + 1) & 1][kk] = *(const LAS bf16x8*)(kbuf + ((nb + 1) * 16 + fr) * 256 + (((kk * 4 + fq) ^ fr) << 4));
        }
        __builtin_amdgcn_sched_barrier(0);
#pragma unroll
        for (int kk = 0; kk < 4; ++kk)
#pragma unroll
            for (int g = 0; g < NG; ++g) s[g][nb] = __builtin_amdgcn_mfma_f32_16x16x32_bf16(kf[nb & 1][kk], qf[g][kk], s[g][nb], 0, 0, 0);
        __builtin_amdgcn_sched_barrier(0);
    }
}
template <int NG, int NBUF, class MaskF, class NextF, class KindF, class OnF>
__device__ __forceinline__ void attn_core(const bf16_t* Kb, const bf16_t* Vt, int ldv, const bf16x8 (&qf)[NG][4], int first, int end, NextF next_tile, MaskF mask, KindF kind, OnF lane_on,
                                          float negB, f32x4 (&O)[NG][8], float (&lrow)[NG]) {
    LAS unsigned char* lds = (LAS unsigned char*)smem_raw;
    const int lane = threadIdx.x & 63, fr = lane & 15, fq = lane >> 4;
#pragma unroll
    for (int g = 0; g < NG; ++g) { lrow[g] = 0.f;
#pragma unroll
        for (int db = 0; db < 8; ++db) O[g][db] = (f32x4){0.f, 0.f, 0.f, 0.f}; }
    constexpr int D = NBUF - 1;
    int tl[NBUF];
    tl[0] = first;
#pragma unroll
    for (int d = 1; d <= D; ++d) tl[d] = (tl[d - 1] < end) ? next_tile(tl[d - 1]) : end;
    if (tl[0] < end) {
        const int wvu = __builtin_amdgcn_readfirstlane(threadIdx.x >> 6);
        asm volatile("s_waitcnt vmcnt(0)" ::: "memory");
#pragma unroll
        for (int d = 0; d < D; ++d) if (tl[d] < end) { attn_dma_k(Kb, tl[d], lds + d * ABUF, wvu, lane); attn_dma_v(Vt, ldv, tl[d], lds + d * ABUF, wvu, lane); }
        int slot = 0;
        for (;;) {
            const int kt = tl[0];
            LAS unsigned char* B = lds + slot * ABUF;
            int nf = 0;
#pragma unroll
            for (int d = 1; d < D; ++d) nf += (tl[d] < end) ? 1 : 0;
            if (D >= 2 && nf >= 2) asm volatile("s_waitcnt vmcnt(8)" ::: "memory");
            else if (D >= 2 && nf == 1) asm volatile("s_waitcnt vmcnt(4)" ::: "memory");
            else asm volatile("s_waitcnt vmcnt(0)" ::: "memory");
            asm volatile("s_waitcnt lgkmcnt(0)" ::: "memory");
            __builtin_amdgcn_s_barrier();
            asm volatile("" ::: "memory");
            if (tl[D] < end) { int ns = slot + D; if (ns >= NBUF) ns -= NBUF; LAS unsigned char* Bn = lds + ns * ABUF; attn_dma_k(Kb, tl[D], Bn, wvu, lane); attn_dma_v(Vt, ldv, tl[D], Bn, wvu, lane); }
            f32x4 s[NG][4];
            attn_qk<NG>(B, qf, s, fr, fq, negB);
            __builtin_amdgcn_sched_barrier(0);
            bf16x8 pf[NG][2];
            const bool masked = kind(kt);
            const bool on = lane_on(kt);
#pragma unroll
            for (int g = 0; g < NG; ++g) {
                float ps = 0.f;
#pragma unroll
                for (int nb = 0; nb < 4; ++nb)
#pragma unroll
                    for (int j = 0; j < 4; ++j) s[g][nb][j] = __builtin_amdgcn_exp2f(s[g][nb][j]);
                if (masked) {
#pragma unroll
                    for (int nb = 0; nb < 4; ++nb)
#pragma unroll
                        for (int j = 0; j < 4; ++j) { const int key = kt * 64 + nb * 16 + fq * 4 + j; s[g][nb][j] = mask(g, key) ? s[g][nb][j] : 0.f; }
                }
#pragma unroll
                for (int nb = 0; nb < 4; ++nb) ps += (s[g][nb][0] + s[g][nb][1]) + (s[g][nb][2] + s[g][nb][3]);
                lrow[g] += on ? ps : 0.f;
#pragma unroll
                for (int p = 0; p < 2; ++p) {
                    union { u32x4 u; bf16x8 b; } cv;
                    cv.u = (u32x4){cvt_pk_bf16(s[g][2 * p][0], s[g][2 * p][1]), cvt_pk_bf16(s[g][2 * p][2], s[g][2 * p][3]),
                                   cvt_pk_bf16(s[g][2 * p + 1][0], s[g][2 * p + 1][1]), cvt_pk_bf16(s[g][2 * p + 1][2], s[g][2 * p + 1][3])};
                    if (!on) cv.u = (u32x4){0u, 0u, 0u, 0u};
                    pf[g][p] = cv.b;
                }
            }
            __builtin_amdgcn_sched_barrier(0);
            {
                union VF { struct { u32x2 a, b; } h; bf16x8 v; };
                VF vf[2][2];
                const LAS unsigned char* vbase = B + KT_BYTES + fr * 128; const int sw = (fr >> 1) & 7;
#pragma unroll
                for (int p = 0; p < 2; ++p) vf[0][p].v = *(const LAS bf16x8*)(vbase + (((4 * p + fq) ^ sw) << 4));
#pragma unroll
                for (int db = 0; db < 8; ++db) {
                    if (db < 7) {
#pragma unroll
                        for (int p = 0; p < 2; ++p) vf[(db + 1) & 1][p].v = *(const LAS bf16x8*)(vbase + (db + 1) * 2048 + (((4 * p + fq) ^ sw) << 4));
                    }
                    __builtin_amdgcn_sched_barrier(0);
#pragma unroll
                    for (int p = 0; p < 2; ++p)
#pragma unroll
                        for (int g = 0; g < NG; ++g) O[g][db] = __builtin_amdgcn_mfma_f32_16x16x32_bf16(vf[db & 1][p].v, pf[g][p], O[g][db], 0, 0, 0);
                    __builtin_amdgcn_sched_barrier(0);
                }
            }
            const int last = tl[D];
#pragma unroll
            for (int d = 0; d < D; ++d) tl[d] = tl[d + 1];
            tl[D] = (last < end) ? next_tile(last) : end;
            if (tl[0] >= end) break;
            ++slot; if (slot >= NBUF) slot = 0;
        }
    }
    asm volatile("s_waitcnt vmcnt(0)" ::: "memory");
    __syncthreads();
}
__device__ __forceinline__ float score_neg_bound(const float* gq, const float* gk) {
    const int lane = threadIdx.x & 63;
    float a = fmaxf(fabsf(gq[lane]), fabsf(gq[lane + 64])), b = fmaxf(fabsf(gk[lane]), fabsf(gk[lane + 64]));
#pragma unroll
    for (int o = 32; o >= 1; o >>= 1) { a = fmaxf(a, __shfl_xor(a, o)); b = fmaxf(b, __shfl_xor(b, o)); }
    return -(a * b * 128.0f * QSCALE * 1.02f);
}
__device__ __forceinline__ void load_qf(bf16x8 (&qf)[4], const bf16_t* qrow, int fq) {
#pragma unroll
    for (int kk = 0; kk < 4; ++kk) qf[kk] = *(const bf16x8*)(qrow + kk * 32 + fq * 8);
}

#define WFF ((bf16_t*)(wsp + OFF_WFF))
#define WD ((bf16_t*)(wsp + OFF_WD))
#define WIN ((bf16_t*)(wsp + OFF_WIN))
#define WOUT ((bf16_t*)(wsp + OFF_WOUT))
#define WMEM ((bf16_t*)(wsp + OFF_WMEM))
#define WC1 ((bf16_t*)(wsp + OFF_WC1))
#define ACT ((bf16_t*)(wsp + OFF_ACT))
#define XB ((bf16_t*)(wsp + OFF_XB))
#define MIX ((bf16_t*)(wsp + OFF_MIX))
#define X2 ((float*)(wsp + OFF_X2))
#define QN ((bf16_t*)(wsp + OFF_QN))
#define KSN ((bf16_t*)(wsp + OFF_KSN))
#define KWN ((bf16_t*)(wsp + OFF_KWN))
#define VST ((bf16_t*)(wsp + OFF_VST))
#define VWT ((bf16_t*)(wsp + OFF_VWT))
#define KCB ((bf16_t*)(wsp + OFF_KCB))
#define VCB ((bf16_t*)(wsp + OFF_VCB))
#define MQN ((bf16_t*)(wsp + OFF_MQN))
#define LA ((float*)(wsp + OFF_LA))
#define GATE ((float*)(wsp + OFF_GATE))
#define ONSA ((float*)(wsp + OFF_ONSA))
#define OCMP ((float*)(wsp + OFF_XB))
#define GLAS ((float*)(wsp + OFF_GLAS))
#define ROPEC ((float*)(wsp + OFF_ROPE))
#define SSQ0 ((u64*)(wsp + OFF_SSQ))
#define SSQM ((u64*)(wsp + OFF_SSQM))
#define MEMB ((bf16_t*)(wsp + OFF_MEMB))
#define KVMEM ((float*)(wsp + OFF_KVMEM))
#define MEMK ((bf16_t*)(wsp + OFF_MEMK))
#define MEMVT ((bf16_t*)(wsp + OFF_MEMVT))
#define HID ((float*)(wsp + OFF_HID))
#define C2 ((float*)(wsp + OFF_C2))
#define KCMP ((bf16_t*)(wsp + OFF_KCMP))
#define VCMPT ((bf16_t*)(wsp + OFF_VCMPT))
#define SEL ((unsigned*)(wsp + OFF_SEL))
#define DEC ((float*)(wsp + OFF_DEC))
#define CBIAS ((float*)(wsp + OFF_CBIAS))
#define PROJ ACT
#define X1 (p.out)
#define X3 (p.out)
#define ROPES (ROPEC + (size_t)S_ * 64)
#define SSQ1 (SSQ0 + S_)
#define SSQ2 (SSQ0 + 2 * S_)
#define SSQ3 (SSQ0 + 3 * S_)
__global__ void __launch_bounds__(512, 2) mega(Params p) {
    cg::grid_group grid = cg::this_grid();
    if (p.ws == nullptr) grid.sync();
    {
        volatile LAS unsigned* stw = (volatile LAS unsigned*)((LAS unsigned char*)smem_raw + LDS_MAIN);
        if (threadIdx.x < 4) stw[threadIdx.x] = 0u;
        __syncthreads();
    }
    const XcdBarrier xbar = xcd_barrier_post((unsigned*)(p.ws + OFF_BAR), (volatile LAS unsigned*)((LAS unsigned char*)smem_raw + LDS_MAIN));
    LAS unsigned char* lds = (LAS unsigned char*)smem_raw;
    const int nblk = gridDim.x, nwaves = nblk * 8, nthreads = nblk * 512;
    int blk;
    {
        __syncthreads();
        const unsigned rank = ((volatile LAS unsigned*)((LAS unsigned char*)smem_raw + LDS_MAIN))[2];
        blk = (nblk == 256 && xbar.x < 8u && rank < 32u) ? (int)(rank * 8u + xbar.x) : (int)blockIdx.x;
        blk = __builtin_amdgcn_readfirstlane(blk);
    }
#define PHASE_IDS unsigned char* wsp = p.ws; asm volatile("" : "+s"(wsp)); int tid = threadIdx.x; asm volatile("" : "+v"(tid)); const int lane = tid & 63, wv = tid >> 6, gwave = blk * 8 + wv, gtid = blk * 512 + tid; (void)lane; (void)wv; (void)gwave; (void)gtid;
    REPS(0) { if (rep_) xcd_barrier(xbar);
        PHASE_IDS
        convert_ffn_weights(p.ffn1_wg, p.ffn1_wu, p.ffn1_wd, p.ffn1_norm, wsp, blk, nblk);
        { const float* w = p.w_in; transpose_convert([=](int k, int n) { const int c = win_src_col(n); return c >= 0 ? w + ((size_t)k * 4648 + c) : (const float*)nullptr; }, p.mix_norm, WIN, 2048, NPJ, LD2, blk, nblk); }
        { const float* w = p.w_out; transpose_convert([=](int k, int n) { return w + ((size_t)k * 2048 + n); }, nullptr, WOUT, 2048, 2048, LD2, blk, nblk); }
        { const float* w = p.w_mem_kv; transpose_convert([=](int k, int n) { return w + ((size_t)k * 1024 + n); }, p.mem_in_norm, WMEM, 2048, 1024, LD2, blk, nblk); }
        { const float* w = p.cmp_w1_k; transpose_convert([=](int k, int n) { return w + ((size_t)k * 256 + n); }, nullptr, WC1, 4096, 256, 4096, blk, nblk); }
        { const float* w = p.cmp_w1_v; transpose_convert([=](int k, int n) { return w + ((size_t)k * 256 + n); }, nullptr, WC1 + 256 * 4096, 4096, 256, 4096, blk, nblk); }
        for (int r16 = blk * 16; r16 < S_ + MEMLEN; r16 += nblk * 16)
#pragma unroll 1
        for (int sub = 0; sub < 2; ++sub) {
            const int r = r16 + wv * 2 + sub;
            const bool ism = r >= S_; const int rr = ism ? r - S_ : r;
            const float* src = (ism ? p.mem : p.x) + (size_t)rr * D_; bf16_t* dst = (ism ? MEMB : XB) + (size_t)rr * LD2;
            float ss = 0.f; f32x4 xv[8];
#pragma unroll
            for (int i = 0; i < 8; ++i) xv[i] = __builtin_nontemporal_load((const GAS f32x4*)((const GAS float*)src + (lane + 64 * i) * 4));
#pragma unroll
            for (int i = 0; i < 8; ++i) {
                const f32x4 v = xv[i];
                ss += v[0] * v[0] + v[1] * v[1] + v[2] * v[2] + v[3] * v[3];
                u32x2 pk = {cvt_pk_bf16(v[0], v[1]), cvt_pk_bf16(v[2], v[3])}; *(GAS u32x2*)((GAS bf16_t*)dst + (lane + 64 * i) * 4) = pk;
            }
            ss = wave_sum(ss);
            if (lane == 0) { if (ism) SSQM[rr] = ssq_fix(ss); else SSQ0[rr] = ssq_fix(ss); }
        }
        for (int i = gtid; i < 3 * S_; i += nthreads) SSQ1[i] = 0ull;
        for (int i = gtid; i < 64 * 64; i += nthreads) ((unsigned*)(wsp + OFF_PCNT))[i] = 0u;
        for (int i = gtid; i < S_ * 64; i += nthreads) {
            const int tok = i >> 6, f = i & 63;
            const float inv = powf(10000.0f, -(float)f * (1.0f / 64.0f));
            const float ang = (float)p.pos[tok] * inv;
            float sn, cs; sincosf(ang, &sn, &cs);
            ROPEC[i] = cs; ROPES[i] = sn;
        }
#if NPH < 4
        for (int i = gtid; i < S_ * LD2 / 8; i += nthreads) ((u32x4*)MIX)[i] = (u32x4){0u, 0u, 0u, 0u};
        for (int i = gtid; i < S_ * 1024 / 4; i += nthreads) ((f32x4*)ONSA)[i] = (f32x4){0.f, 0.f, 0.f, 0.f};
#endif
    }
    xcd_barrier(xbar);
    REPS(1) { if (rep_) xcd_barrier(xbar);
        PHASE_IDS
        pg8::Gemm g{XB, WFF, S_, 11264, 2048, LD2, LD2}; pg8::StaticOrder so; so.init(g.M, g.N, nblk, blk);
        EpiGateUp e{ACT, SSQ0};
        pg8::gemm_phase(lds, g, so, e);
        pg8::Gemm g2{MEMB, WMEM, 256, 1024, 2048, LD2, LD2}; pg8::StaticOrder so2; so2.init(g2.M, g2.N, nblk, blk + 4 >= nblk ? blk + 4 - nblk : blk + 4);
        EpiMemKV e2{KVMEM, SSQM};
        pg8::gemm_phase(lds, g2, so2, e2);
    }
    xcd_barrier(xbar);
    {
        PHASE_IDS
        pg8::Gemm g{ACT, WD, S_, 2048, FF_, LDF, LDF}; pg8::StaticOrder so; so.init(g.M, g.N, nblk, blk);
        EpiResid e{p.x, X1, XB, SSQ1, 0.5f};
        pg8::gemm_phase(lds, g, so, e);
    }
    xcd_barrier(xbar);
    {
        PHASE_IDS
        pg8::Gemm g{XB, WIN, S_, NPJ, 2048, LD2, LD2}; pg8::StaticOrder so; so.init(g.M, g.N, nblk, blk);
        EpiScaleBf16 e{PROJ, NPJ, SSQ1};
        pg8::gemm_phase(lds, g, so, e);
    }
    xcd_barrier(xbar);
    REPS(4) { if (rep_) xcd_barrier(xbar);
        PHASE_IDS
        if (rep_ && (DUPSUB & 8)) continue;
        convert_ffn_weights(p.ffn2_wg, p.ffn2_wu, p.ffn2_wd, p.ffn2_norm, wsp, blk, nblk);
#if NPH >= 2
        for (int tok0 = gwave; tok0 < S_; tok0 += 2 * nwaves) {
            bf16_t ar2[2][16], br2[2][16], cr2[2][8]; float cs2[2], sn2[2];
#pragma unroll
            for (int tt = 0; tt < 2; ++tt) {
            const int tok = (tok0 + tt * nwaves < S_) ? tok0 + tt * nwaves : tok0;
            const GAS bf16_t* pr = (const GAS bf16_t*)(PROJ + (size_t)tok * NPJ);
#pragma unroll
            for (int v = 0; v < 16; ++v) { const int col = (v < 8) ? PC_NQ + v * 128 : (v < 10) ? PC_KS + (v - 8) * 128 : (v < 12) ? PC_KW + (v - 10) * 128 : PC_MQ + (v - 12) * 128;
                ar2[tt][v] = pr[col + lane]; br2[tt][v] = pr[col + 64 + lane]; }
#pragma unroll
            for (int g = 0; g < 2; ++g) { cr2[tt][g * 4 + 0] = pr[PC_KC + g * 128 + lane]; cr2[tt][g * 4 + 1] = pr[PC_KC + g * 128 + 64 + lane]; cr2[tt][g * 4 + 2] = pr[PC_VC + g * 128 + lane]; cr2[tt][g * 4 + 3] = pr[PC_VC + g * 128 + 64 + lane]; }
            cs2[tt] = ((const GAS float*)ROPEC)[tok * 64 + lane]; sn2[tt] = ((const GAS float*)ROPES)[tok * 64 + lane];
            }
            const float gq0 = p.q_norm[lane], gq1 = p.q_norm[64 + lane], gs0 = p.k_norm[128 + lane], gs1 = p.k_norm[192 + lane], gw0 = p.k_norm[256 + lane], gw1 = p.k_norm[320 + lane], gm0 = p.mem_q_norm[lane], gm1 = p.mem_q_norm[64 + lane];
#pragma unroll
            for (int tt = 0; tt < 2; ++tt) {
            const int tok = tok0 + tt * nwaves; if (tok >= S_) break;
            const float cs = cs2[tt], sn = sn2[tt];
#pragma unroll
            for (int v = 0; v < 16; ++v) {
                GAS bf16_t* dst; float g0, g1; bool rope = true;
                if (v < 8) { g0 = gq0; g1 = gq1; dst = (GAS bf16_t*)(QN + ((size_t)v * S_ + tok) * 128); }
                else if (v < 10) { g0 = gs0; g1 = gs1; dst = (GAS bf16_t*)(KSN + ((size_t)(v - 8) * S_ + tok) * 128); }
                else if (v < 12) { g0 = gw0; g1 = gw1; dst = (GAS bf16_t*)(KWN + ((size_t)(v - 10) * S_ + tok) * 128); }
                else { g0 = gm0; g1 = gm1; dst = (GAS bf16_t*)(MQN + ((size_t)(v - 12) * S_ + tok) * 128); rope = false; }
                float a = bf2f(ar2[tt][v]), b = bf2f(br2[tt][v]);
                const float ss = wave_sum(a * a + b * b); const float r = rsqrtf(ss * (1.0f / 128.0f) + EPS_);
                a *= r * g0; b *= r * g1;
                float o1 = a, o2 = b;
                if (rope) { o1 = a * cs - b * sn; o2 = b * cs + a * sn; }
                if (v < 8 || v >= 12) { o1 *= QSCALE; o2 *= QSCALE; }
                dst[lane] = f2bf(o1); dst[64 + lane] = f2bf(o2);
            }
#pragma unroll
            for (int g = 0; g < 2; ++g) {
                GAS bf16_t* kd = (GAS bf16_t*)(KCB + ((size_t)g * S_ + tok) * 128); GAS bf16_t* vd = (GAS bf16_t*)(VCB + ((size_t)g * S_ + tok) * 128);
                kd[lane] = cr2[tt][g * 4 + 0]; kd[64 + lane] = cr2[tt][g * 4 + 1]; vd[lane] = cr2[tt][g * 4 + 2]; vd[64 + lane] = cr2[tt][g * 4 + 3];
            }
            }
        }
        {
            PHASE_IDS
            LAS bf16_t* tl = (LAS bf16_t*)lds;
            for (int it = blk; it < 4 * 128; it += nblk) {
                const int which = it >> 8, g = (it >> 7) & 1, t0 = (it & 127) * 64;
                const int col = (which ? PC_VW : PC_VS) + g * 128; bf16_t* dstT = (which ? VWT : VST) + (size_t)g * 128 * S_;
                __syncthreads();
#pragma unroll
                for (int i = 0; i < 2; ++i) { const int c = tid + i * 512, row = c >> 4, ch = c & 15;
                    *(LAS u32x4*)(tl + row * 136 + ch * 8) = *(const u32x4*)(PROJ + (size_t)(t0 + row) * NPJ + col + ch * 8); }
                __syncthreads();
                { const int dv = tid >> 2, tc = (tid & 3) * 16; unsigned pk[8];
#pragma unroll
                  for (int i = 0; i < 8; ++i) pk[i] = (unsigned)tl[vperm_inv(tc + 2 * i) * 136 + dv] | ((unsigned)tl[vperm_inv(tc + 2 * i + 1) * 136 + dv] << 16);
                  *(u32x4*)(dstT + (size_t)dv * S_ + t0 + tc) = (u32x4){pk[0], pk[1], pk[2], pk[3]};
                  *(u32x4*)(dstT + (size_t)dv * S_ + t0 + tc + 8) = (u32x4){pk[4], pk[5], pk[6], pk[7]}; }
            }
            __syncthreads();
        }
        for (int i = gtid; i < S_ * 64; i += nthreads) {
            const int tok = i >> 6, c0 = (i & 63) * 4; const GAS bf16_t* pr = (const GAS bf16_t*)(PROJ + (size_t)tok * NPJ + PC_GA);
            const u32x4 ga0 = *(const GAS u32x4*)pr, ga1 = *(const GAS u32x4*)(pr + 8);
            f32x4 xacc = *(const GAS f32x4*)((const GAS float*)p.gla_ba + c0);
#pragma unroll
            for (int r = 0; r < 16; ++r) { const unsigned w = (r < 8) ? ga0[(r & 7) >> 1] : ga1[(r & 7) >> 1]; const float gv = (r & 1) ? __uint_as_float(w & 0xffff0000u) : __uint_as_float(w << 16);
                xacc += *(const GAS f32x4*)((const GAS float*)p.gla_wa + r * 256 + c0) * gv; }
            f32x4 o;
#pragma unroll
            for (int e = 0; e < 4; ++e) { const float xv = xacc[e]; o[e] = (fminf(xv, 0.f) - log1pf(__expf(-fabsf(xv)))) * (1.0f / 16.0f); }
            *(GAS f32x4*)((GAS float*)LA + (size_t)tok * 256 + c0) = o;
        }
        for (int i = gtid; i < S_ * 24; i += nthreads) { const int tok = i / 24, j = i % 24; GATE[i] = sigmoid_f(bf2f(PROJ[(size_t)tok * NPJ + PC_NG + j])); }
        for (int it = gwave; it < 4 * 256; it += nwaves) {
            const int h = it >> 8, m = it & 255; const float* kr = KVMEM + (size_t)m * 1024 + h * 128;
            float a = kr[lane], b = kr[64 + lane]; const float ss = wave_sum(a * a + b * b); const float r = rsqrtf(ss * (1.0f / 128.0f) + EPS_);
            MEMK[((size_t)h * 256 + m) * 128 + lane] = f2bf(a * r * p.mem_k_norm[lane]); MEMK[((size_t)h * 256 + m) * 128 + 64 + lane] = f2bf(b * r * p.mem_k_norm[64 + lane]);
        }
        for (int i = gtid; i < 4 * 128 * 256; i += nthreads) { const int m = i & 255, dv = (i >> 8) & 127, h = i >> 15; MEMVT[(i & ~63) | vperm(i & 63)] = f2bf(KVMEM[(size_t)m * 1024 + 512 + h * 128 + dv]); }
        for (int it = gwave; it < 512; it += nwaves) {
            const int kv = it >> 8, c = it & 255; const float* pf = kv ? p.cmp_pos_v : p.cmp_pos_k; const bf16_t* wr_ = WC1 + ((size_t)kv * 256 + c) * 4096;
            float s = 0.f;
            for (int k = lane; k < 4096; k += 64) s += pf[k] * bf2f(wr_[k]);
            s = wave_sum(s); if (lane == 0) CBIAS[it * 32] = s;
        }
#endif
    }
    xcd_barrier(xbar);
    REPS(5) { if (rep_) xcd_barrier(xbar);
        PHASE_IDS
#if NPH >= 4
        if (!rep_ || (DUPSUB & 1))
        for (int it = (blk >= 128 ? blk - 128 : blk + nblk - 128); it < 128; it += nblk) {
            PHASE_IDS
            const int fr = lane & 15, fq = lane >> 4;
            const int combo = it >> 5, kv = combo >> 1, g = combo & 1, r0 = (it & 31) * 16;
            const bf16_t* A = (kv ? VCB : KCB) + (size_t)g * S_ * 128 + (size_t)r0 * 2048 + (size_t)fr * 2048 + wv * 512 + fq * 8;
            const bf16_t* W = WC1 + (size_t)kv * 256 * 4096 + (size_t)fr * 4096 + wv * 512 + fq * 8;
            f32x4 acc[16];
#pragma unroll
            for (int n = 0; n < 16; ++n) acc[n] = (f32x4){0.f, 0.f, 0.f, 0.f};
#pragma unroll 1
            for (int ks = 0; ks < 16; ++ks) {
                const bf16x8 af = *(const bf16x8*)(A + ks * 32);
#pragma unroll
                for (int n = 0; n < 16; ++n) { const bf16x8 bfv = *(const bf16x8*)(W + (size_t)n * 16 * 4096 + ks * 32); acc[n] = __builtin_amdgcn_mfma_f32_16x16x32_bf16(af, bfv, acc[n], 0, 0, 0); }
            }
            LAS float* part = (LAS float*)lds; LAS float* hidL = (LAS float*)(lds + 131072);
            __syncthreads();
#pragma unroll
            for (int n = 0; n < 16; ++n)
#pragma unroll
                for (int j = 0; j < 4; ++j) part[(wv * 16 + fq * 4 + j) * 256 + n * 16 + fr] = acc[n][j];
            __syncthreads();
#pragma unroll
            for (int i = 0; i < 8; ++i) { const int idx = tid + i * 512, r = idx >> 8, c = idx & 255; float sacc = CBIAS[(kv * 256 + c) * 32];
#pragma unroll
                for (int w = 0; w < 8; ++w) sacc += part[(w * 16 + r) * 256 + c];
                hidL[idx] = silu_f(sacc); }
            __syncthreads();
            {
                const int r = tid >> 5, c4 = (tid & 31) * 4, n = r0 + r; const float* w2 = (kv ? p.cmp_w2_v : p.cmp_w2_k) + c4;
                f32x4 o = (f32x4){0.f, 0.f, 0.f, 0.f};
#pragma unroll 8
                for (int k = 0; k < 256; ++k) { const float hv = hidL[r * 256 + k]; const f32x4 w = *(const f32x4*)(w2 + k * 128); o += w * hv; }
                if (n >= 511) o = (f32x4){0.f, 0.f, 0.f, 0.f};
                if (kv == 0) {
                    float ss = o[0] * o[0] + o[1] * o[1] + o[2] * o[2] + o[3] * o[3];
                    ss += __shfl_xor(ss, 1); ss += __shfl_xor(ss, 2); ss += __shfl_xor(ss, 4); ss += __shfl_xor(ss, 8); ss += __shfl_xor(ss, 16);
                    const float rs = rsqrtf(ss * (1.0f / 128.0f) + EPS_);
                    const f32x4 gn = *(const f32x4*)(p.k_norm + c4); o = o * rs * gn;
                    f32x4 pr; pr[0] = __shfl_xor(o[0], 16); pr[1] = __shfl_xor(o[1], 16); pr[2] = __shfl_xor(o[2], 16); pr[3] = __shfl_xor(o[3], 16);
                    const int tk = (n < 511) ? 16 * n + 31 : 0; const int fi = c4 & 63;
                    const f32x4 cs = *(const f32x4*)(ROPEC + tk * 64 + fi), sn = *(const f32x4*)(ROPES + tk * 64 + fi);
                    f32x4 res;
                    if (c4 < 64) res = o * cs - pr * sn; else res = o * cs + pr * sn;
                    u32x2 pk = {cvt_pk_bf16(res[0], res[1]), cvt_pk_bf16(res[2], res[3])};
                    *(u32x2*)(KCMP + ((size_t)g * 512 + n) * 128 + c4) = pk;
                } else {
#pragma unroll
                    for (int j = 0; j < 4; ++j) { const unsigned mine = f2bf(o[j]); const unsigned oth = __shfl_xor(mine, 32);
                        if (lane < 32) __hip_atomic_store((unsigned*)(VCMPT + ((size_t)g * 128 + c4 + j) * 512 + ((n & ~63) | vperm(n & 63))), mine | (oth << 16), __ATOMIC_RELAXED, __HIP_MEMORY_SCOPE_AGENT); }
                }
            }
            __syncthreads();
        }
#endif
#if NPH >= 3
        if (!rep_ || (DUPSUB & 2))
        for (int it = blk; it < 256 + 128; it += nblk) {
            PHASE_IDS
            const int fr = lane & 15, fq = lane >> 4;
            bf16x8 qf[2][4]; f32x4 O[2][8]; float lrow[2];
            if (it < 256) {
                const int g = it >> 7, t0 = (it & 127) * 64; const int tg = wv & 3, hp = wv >> 2; const int tok = t0 + tg * 16 + fr;
#pragma unroll
                for (int q = 0; q < 2; ++q) load_qf(qf[q], QN + ((size_t)(g * 4 + hp * 2 + q) * S_ + tok) * 128, fq);
                const int first = (t0 >= 512) ? (t0 >> 6) - 8 : 0, end = (t0 >> 6) + 1;
                attn_core<2, 4>(KWN + (size_t)g * S_ * 128, VWT + (size_t)g * 128 * S_, S_, qf, first, end, [](int kt) { return kt + 1; },
                          [=](int, int key) { return key <= tok && key > tok - 512; }, [=](int kt) { return kt == end - 1 || (t0 >= 512 && kt == first); }, [](int) { return true; },
                          score_neg_bound(p.q_norm, p.k_norm + 256), O, lrow);
#pragma unroll
                for (int q = 0; q < 2; ++q) {
                    float l = lrow[q]; l += __shfl_xor(l, 16); l += __shfl_xor(l, 32);
                    const int hl = hp * 2 + q; const float sc = GATE[tok * 24 + g * 12 + hl * 3 + 2] / fmaxf(l, 1e-30f);
#pragma unroll
                    for (int db = 0; db < 8; ++db) *(f32x4*)(ONSA + (size_t)tok * 1024 + (g * 4 + hl) * 128 + db * 16 + fq * 4) = O[q][db] * sc;
                }
            } else {
                const int im = it - 256, h = im >> 5, t0 = (im & 31) * 256; int tokq[2];
#pragma unroll
                for (int q = 0; q < 2; ++q) { tokq[q] = t0 + wv * 32 + q * 16 + fr; load_qf(qf[q], MQN + ((size_t)h * S_ + tokq[q]) * 128, fq); }
                attn_core<2, 4>(MEMK + (size_t)h * 256 * 128, MEMVT + (size_t)h * 128 * 256, 256, qf, 0, 4, [](int kt) { return kt + 1; },
                          [](int, int) { return true; }, [](int) { return false; }, [](int) { return true; }, score_neg_bound(p.mem_q_norm, p.mem_k_norm), O, lrow);
#pragma unroll
                for (int q = 0; q < 2; ++q) {
                    float l = lrow[q]; l += __shfl_xor(l, 16); l += __shfl_xor(l, 32); const float sc = 1.0f / fmaxf(l, 1e-30f);
#pragma unroll
                    for (int db = 0; db < 8; ++db) { const f32x4 v = O[q][db] * sc; u32x2 pk = {cvt_pk_bf16(v[0], v[1]), cvt_pk_bf16(v[2], v[3])};
                        *(u32x2*)(MIX + (size_t)tokq[q] * LD2 + 1536 + h * 128 + db * 16 + fq * 4) = pk; }
                }
            }
        }
#endif
#if NPH >= 2
        if (!rep_ || (DUPSUB & 4))
        {
            PHASE_IDS
            LAS float* Bc = (LAS float*)lds; LAS float* Kt = Bc + 4096; LAS float* Vv = Kt + 4096;
            for (int it = blk; it < 512; it += nblk) {
                const int h = it >> 7, c = it & 127, tk0 = c * 64;
                __syncthreads();
                for (int i = tid; i < 4096; i += 512) Bc[i] = LA[(size_t)(tk0 + (i >> 6)) * 256 + h * 64 + (i & 63)];
                u32x4 kraw, vraw[2];
                { const int j = tid >> 3, d8 = (tid & 7) * 8; kraw = *(const u32x4*)(PROJ + (size_t)(tk0 + j) * NPJ + PC_GK + h * 64 + d8); }
#pragma unroll
                for (int q = 0; q < 2; ++q) { const int cix = tid + q * 512, j = cix >> 4, e8 = (cix & 15) * 8; vraw[q] = *(const u32x4*)(PROJ + (size_t)(tk0 + j) * NPJ + PC_GV + h * 128 + e8); }
                __syncthreads();
                if (tid < 64) { float run = 0.f; for (int i = 0; i < 64; ++i) { run += Bc[i * 64 + tid]; Bc[i * 64 + tid] = run; } DEC[(h * 128 + c) * 64 + tid] = __expf(run); }
                __syncthreads();
                { const int j = tid >> 3, d8 = (tid & 7) * 8;
#pragma unroll
                  for (int e = 0; e < 4; ++e) { const unsigned w = kraw[e]; const int d = d8 + 2 * e;
                      Kt[j * 64 + d] = __uint_as_float(w << 16) * __expf(Bc[63 * 64 + d] - Bc[j * 64 + d]);
                      Kt[j * 64 + d + 1] = __uint_as_float(w & 0xffff0000u) * __expf(Bc[63 * 64 + d + 1] - Bc[j * 64 + d + 1]); } }
#pragma unroll
                for (int q = 0; q < 2; ++q) { const int cix = tid + q * 512, j = cix >> 4, e8 = (cix & 15) * 8;
#pragma unroll
                    for (int e = 0; e < 4; ++e) { const unsigned w = vraw[q][e]; Vv[j * 128 + e8 + 2 * e] = __uint_as_float(w << 16); Vv[j * 128 + e8 + 2 * e + 1] = __uint_as_float(w & 0xffff0000u); } }
                __syncthreads();
                { const int dg = tid >> 5, eg = tid & 31; f32x4 a[4];
#pragma unroll
                  for (int r = 0; r < 4; ++r) a[r] = (f32x4){0.f, 0.f, 0.f, 0.f};
#pragma unroll 4
                  for (int j = 0; j < 64; ++j) { const f32x4 k4 = *(const LAS f32x4*)(Kt + j * 64 + dg * 4); const f32x4 v4 = *(const LAS f32x4*)(Vv + j * 128 + eg * 4);
#pragma unroll
                      for (int r = 0; r < 4; ++r) a[r] += v4 * k4[r]; }
                  GAS float* dst = (GAS float*)GLAS + (((size_t)(h * 128 + c)) * 64 + dg * 4) * 128 + eg * 4;
#pragma unroll
                  for (int r = 0; r < 4; ++r) *(GAS f32x4*)(dst + r * 128) = a[r]; }
            }
            __syncthreads();
        }
#endif
    }
    xcd_barrier(xbar);
#ifdef XTRA6
    xcd_barrier(xbar);
#endif
    {
        PHASE_IDS
#if NPH >= 2
        if (gtid < 32768) {
            const int h = gtid >> 13, rem = gtid & 8191, d = rem >> 7;
            float carry = 0.f; float* ptr = GLAS + (size_t)h * 128 * 8192 + rem; const float* dc = DEC + h * 128 * 64 + d;
            for (int c0 = 0; c0 < 128; c0 += 16) { float tmp[16], dd[16];
#pragma unroll
                for (int c = 0; c < 16; ++c) { tmp[c] = ptr[(size_t)(c0 + c) * 8192]; dd[c] = dc[(c0 + c) * 64]; }
#pragma unroll
                for (int c = 0; c < 16; ++c) { ptr[(size_t)(c0 + c) * 8192] = carry; carry = carry * dd[c] + tmp[c]; } }
        }
#endif
#if NPH >= 4
        for (int it = blk; it < 256; it += nblk) {
            PHASE_IDS
            const int fr = lane & 15, fq = lane >> 4;
            const int g = it >> 7, t0 = (it & 127) * 64; const int tg = wv & 3, hp = wv >> 2; const int tok = t0 + tg * 16 + fr;
            bf16x8 qf[2][4]; f32x4 O[2][8]; float lrow[2]; const float negB = score_neg_bound(p.q_norm, p.k_norm);
#pragma unroll
            for (int q = 0; q < 2; ++q) load_qf(qf[q], QN + ((size_t)(g * 4 + hp * 2 + q) * S_ + tok) * 128, fq);
            int ntile = ((t0 + 32) >> 4) / 64 + 1; if (ntile > 8) ntile = 8;
            const bf16_t* Kb = KCMP + (size_t)g * 512 * 128; const bf16_t* Vt = VCMPT + (size_t)g * 128 * 512;
            attn_core<2, 2>(Kb, Vt, 512, qf, 0, ntile, [](int kt) { return kt + 1; }, [=](int, int key) { return 16 * key + 31 <= tok; }, [=](int kt) { return 1024 * kt + 1039 > t0; }, [](int) { return true; }, negB, O, lrow);
            float invl[2];
#pragma unroll
            for (int q = 0; q < 2; ++q) {
                float l = lrow[q]; l += __shfl_xor(l, 16); l += __shfl_xor(l, 32); invl[q] = 1.0f / fmaxf(l, 1e-30f);
                const int hl = hp * 2 + q; const float sc = GATE[tok * 24 + g * 12 + hl * 3 + 0] * invl[q];
#pragma unroll
                for (int db = 0; db < 8; ++db) { float* op = OCMP + (size_t)tok * 1024 + (g * 4 + hl) * 128 + db * 16 + fq * 4; *(f32x4*)op = O[q][db] * sc; }
            }
            LAS float* imp = (LAS float*)(lds + A_IMP);
            for (int i = tid; i < 2 * 64 * 128; i += 512) imp[i] = 0.f;
            float prev_c3 = 0.f;
            const int wvs = __builtin_amdgcn_readfirstlane(wv);
            __syncthreads();
            attn_dma_k(Kb, 0, lds, wvs, lane);
            for (int kt = 0; kt < ntile; ++kt) {
                LAS unsigned char* kb = lds + (kt & 1) * ABUF;
                asm volatile("s_waitcnt vmcnt(0)" ::: "memory");
                __syncthreads();
                if (kt + 1 < ntile) attn_dma_k(Kb, kt + 1, lds + ((kt + 1) & 1) * ABUF, wvs, lane);
                f32x4 s[2][4]; attn_qk<2>(kb, qf, s, fr, fq, negB);
#pragma unroll
                for (int nb = 0; nb < 4; ++nb) {
                    float own = 0.f, c3 = 0.f;
#pragma unroll
                    for (int q = 0; q < 2; ++q) {
                        float pj[4];
#pragma unroll
                        for (int j = 0; j < 4; ++j) { const int key = kt * 64 + nb * 16 + fq * 4 + j; pj[j] = (16 * key + 31 <= tok) ? __builtin_amdgcn_exp2f(s[q][nb][j]) * invl[q] : 0.f; }
                        own += 2.f * (pj[0] + pj[1] + pj[2]) + pj[3]; c3 += pj[3];
                    }
                    const float a = __shfl(c3, (lane + 48) & 63), b = __shfl(prev_c3, (lane + 48) & 63);
                    const float val = own + (fq > 0 ? a : b);
                    prev_c3 = c3;
                    imp[(hp * 64 + tg * 16 + fr) * 128 + kt * 16 + nb * 4 + fq] = val;
                }
            }
            __syncthreads();
            LAS float* scl = (LAS float*)(lds + A_SCL) + wv * 128;
            for (int ti = 0; ti < 8; ++ti) {
                const int tl = wv * 8 + ti, tk = t0 + tl, cur = tk >> 6;
                float my[2]; bool caus[2];
#pragma unroll
                for (int hf = 0; hf < 2; ++hf) { const int m = lane + 64 * hf; caus[hf] = (m * 64 <= tk); const bool forced = (m == 0) | (m == cur) | (m == cur - 1);
                    my[hf] = caus[hf] ? (forced ? 1e4f : imp[tl * 128 + m] + imp[(64 + tl) * 128 + m]) : -1e4f; scl[m] = my[hf]; }
                asm volatile("s_waitcnt lgkmcnt(0)" ::: "memory");
                int rk0 = 0, rk1 = 0;
                for (int mm = 0; mm < 128; ++mm) { const float v = scl[mm]; rk0 += (v > my[0]) || (v == my[0] && mm < lane); rk1 += (v > my[1]) || (v == my[1] && mm < lane + 64); }
                const u64 b0 = __ballot(rk0 < 16 && caus[0]), b1 = __ballot(rk1 < 16 && caus[1]);
                if (lane == 0) *(u32x4*)(SEL + ((size_t)g * S_ + tk) * 4) = (u32x4){(unsigned)b0, (unsigned)(b0 >> 32), (unsigned)b1, (unsigned)(b1 >> 32)};
                asm volatile("s_waitcnt lgkmcnt(0)" ::: "memory");
            }
            __syncthreads();
        }
#endif
    }
    xcd_barrier(xbar);
    REPS(7) { if (rep_) xcd_barrier(xbar);
        PHASE_IDS
        if (rep_ && (DUPSUB & 8)) continue;
#if NPH >= 4
        for (int pi = blk; pi < 256; pi += nblk)
#pragma unroll 1
        for (int half = 0; half < 2; ++half) {
            PHASE_IDS
            const int fr = lane & 15, fq = lane >> 4;
            const int g = pi & 1, u = half ? (pi >> 1) : 255 - (pi >> 1), t0 = u * 32; const int tg = wv & 1, hl = wv >> 1; const int tl = tg * 16 + fr, tok = t0 + tl;
            LAS unsigned* bm = (LAS unsigned*)(lds + A_BM); LAS unsigned* un = (LAS unsigned*)(lds + A_UN);
            __syncthreads();
            if (tid < 4) un[tid] = 0u;
            __syncthreads();
            if (tid < 128) { const unsigned w = SEL[((size_t)g * S_ + t0 + (tid >> 2)) * 4 + (tid & 3)]; bm[tid] = w; atomicOr((unsigned*)&un[tid & 3], w); }
            __syncthreads();
            bf16x8 qf[1][4]; f32x4 O[1][8]; float lrow[1];
            load_qf(qf[0], QN + ((size_t)(g * 4 + hl) * S_ + tok) * 128, fq);
            const int end = (t0 >> 6) + 1;
            attn_core<1, 4>(KSN + (size_t)g * S_ * 128, VST + (size_t)g * 128 * S_, S_, qf, 0, end,
                      [=](int kt) { int n = kt + 1; while (n < end && !((un[n >> 5] >> (n & 31)) & 1u)) ++n; return n; },
                      [=](int, int key) { const int kt = key >> 6; return ((bm[tl * 4 + (kt >> 5)] >> (kt & 31)) & 1u) && key <= tok; },
                      [=](int kt) { return kt == end - 1; }, [=](int kt) { return ((bm[tl * 4 + (kt >> 5)] >> (kt & 31)) & 1u) != 0u; },
                      score_neg_bound(p.q_norm, p.k_norm + 128), O, lrow);
            {
                float l = lrow[0]; l += __shfl_xor(l, 16); l += __shfl_xor(l, 32);
                const float sc = GATE[tok * 24 + g * 12 + hl * 3 + 1] / fmaxf(l, 1e-30f);
#pragma unroll
                for (int db = 0; db < 8; ++db) { const size_t o = (size_t)tok * 1024 + (g * 4 + hl) * 128 + db * 16 + fq * 4; O[0][db] = *(const GAS f32x4*)((const GAS float*)ONSA + o) + *(const GAS f32x4*)((const GAS float*)OCMP + o) + O[0][db] * sc; }
#pragma unroll
                for (int db = 0; db < 8; ++db) { const f32x4 v = O[0][db];
                    u32x2 pk = {cvt_pk_bf16(v[0], v[1]), cvt_pk_bf16(v[2], v[3])}; *(GAS u32x2*)((GAS bf16_t*)MIX + (size_t)tok * LD2 + 512 + (g * 4 + hl) * 128 + db * 16 + fq * 4) = pk; }
            }
        }
#elif NPH == 3
        for (int i = gtid; i < S_ * 256; i += nthreads) { const int tok = i >> 8, c4 = (i & 255) * 4; const f32x4 v = *(const f32x4*)(ONSA + (size_t)tok * 1024 + c4);
            u32x2 pk = {cvt_pk_bf16(v[0], v[1]), cvt_pk_bf16(v[2], v[3])}; *(u32x2*)(MIX + (size_t)tok * LD2 + 512 + c4) = pk; }
#endif
#if NPH >= 2
        {
            PHASE_IDS
            LAS float* Bc = (LAS float*)lds; LAS float* Qt = Bc + 4096; LAS float* Kh = Qt + 4352; LAS float* Vv = Kh + 4352; LAS float* Ss = Vv + 8192; LAS float* Aa = Ss + 8192;
            for (int it = blk; it < 512; it += nblk) {
                const int h = it >> 7, c = it & 127, tk0 = c * 64;
                __syncthreads();
                for (int i = tid; i < 4096; i += 512) Bc[i] = LA[(size_t)(tk0 + (i >> 6)) * 256 + h * 64 + (i & 63)];
                u32x4 qraw, kraw, vraw[2]; f32x4 sraw[4];
                { const int j = tid >> 3, d8 = (tid & 7) * 8; qraw = *(const u32x4*)(PROJ + (size_t)(tk0 + j) * NPJ + PC_GQ + h * 64 + d8); kraw = *(const u32x4*)(PROJ + (size_t)(tk0 + j) * NPJ + PC_GK + h * 64 + d8); }
#pragma unroll
                for (int q = 0; q < 2; ++q) { const int cix = tid + q * 512, j = cix >> 4, e8 = (cix & 15) * 8; vraw[q] = *(const u32x4*)(PROJ + (size_t)(tk0 + j) * NPJ + PC_GV + h * 128 + e8); }
#pragma unroll
                for (int q = 0; q < 4; ++q) sraw[q] = *(const f32x4*)(GLAS + ((size_t)(h * 128 + c)) * 8192 + (tid + q * 512) * 4);
                __syncthreads();
                if (tid < 64) { float run = 0.f; for (int i = 0; i < 64; ++i) { run += Bc[i * 64 + tid]; Bc[i * 64 + tid] = run; } }
                __syncthreads();
                { const int j = tid >> 3, d8 = (tid & 7) * 8;
#pragma unroll
                  for (int e = 0; e < 4; ++e) { const int d = d8 + 2 * e; const float b0 = Bc[j * 64 + d], b1 = Bc[j * 64 + d + 1];
                      Qt[d * 68 + j] = __uint_as_float(qraw[e] << 16) * 0.125f * __expf(b0); Qt[(d + 1) * 68 + j] = __uint_as_float(qraw[e] & 0xffff0000u) * 0.125f * __expf(b1);
                      Kh[d * 68 + j] = __uint_as_float(kraw[e] << 16) * __expf(-b0); Kh[(d + 1) * 68 + j] = __uint_as_float(kraw[e] & 0xffff0000u) * __expf(-b1); } }
#pragma unroll
                for (int q = 0; q < 2; ++q) { const int cix = tid + q * 512, j = cix >> 4, e8 = (cix & 15) * 8;
#pragma unroll
                    for (int e = 0; e < 4; ++e) { const unsigned w = vraw[q][e]; Vv[j * 128 + e8 + 2 * e] = __uint_as_float(w << 16); Vv[j * 128 + e8 + 2 * e + 1] = __uint_as_float(w & 0xffff0000u); } }
#pragma unroll
                for (int q = 0; q < 4; ++q) *(LAS f32x4*)(Ss + (tid + q * 512) * 4) = sraw[q];
                __syncthreads();
                { const int i0 = (tid >> 5) * 4, j0 = (tid & 31) * 2; f32x4 a0 = (f32x4){0.f, 0.f, 0.f, 0.f}, a1 = a0;
                  if (j0 <= i0 + 3) {
#pragma unroll 4
                      for (int d = 0; d < 64; ++d) { const f32x4 q4 = *(const LAS f32x4*)(Qt + d * 68 + i0); const float k0v = Kh[d * 68 + j0], k1v = Kh[d * 68 + j0 + 1]; a0 += q4 * k0v; a1 += q4 * k1v; }
                  }
#pragma unroll
                  for (int r = 0; r < 4; ++r) { a0[r] = (j0 <= i0 + r) ? a0[r] : 0.f; a1[r] = (j0 + 1 <= i0 + r) ? a1[r] : 0.f; }
                  *(LAS f32x4*)(Aa + j0 * 68 + i0) = a0; *(LAS f32x4*)(Aa + (j0 + 1) * 68 + i0) = a1; }
                __syncthreads();
                { const int i0 = (tid >> 5) * 4, e0 = (tid & 31) * 4; f32x4 o[4];
#pragma unroll
                  for (int r = 0; r < 4; ++r) o[r] = (f32x4){0.f, 0.f, 0.f, 0.f};
#pragma unroll 4
                  for (int d = 0; d < 64; ++d) { const f32x4 q4 = *(const LAS f32x4*)(Qt + d * 68 + i0); const f32x4 s4 = *(const LAS f32x4*)(Ss + d * 128 + e0);
#pragma unroll
                      for (int r = 0; r < 4; ++r) o[r] += s4 * q4[r]; }
#pragma unroll 4
                  for (int j = 0; j < i0 + 4; ++j) { const f32x4 a4 = *(const LAS f32x4*)(Aa + j * 68 + i0); const f32x4 v4 = *(const LAS f32x4*)(Vv + j * 128 + e0);
#pragma unroll
                      for (int r = 0; r < 4; ++r) o[r] += v4 * a4[r]; }
                  const f32x4 gn = *(const GAS f32x4*)((const GAS float*)p.gla_onorm + e0);
                  u32x2 graw[4];
#pragma unroll
                  for (int r = 0; r < 4; ++r) graw[r] = *(const GAS u32x2*)((const GAS bf16_t*)PROJ + (size_t)(tk0 + i0 + r) * NPJ + PC_GR + h * 128 + e0);
#pragma unroll
                  for (int r = 0; r < 4; ++r) {
                      float ss = o[r][0] * o[r][0] + o[r][1] * o[r][1] + o[r][2] * o[r][2] + o[r][3] * o[r][3];
                      ss += __shfl_xor(ss, 1); ss += __shfl_xor(ss, 2); ss += __shfl_xor(ss, 4); ss += __shfl_xor(ss, 8); ss += __shfl_xor(ss, 16);
                      const float rr = rsqrtf(ss * (1.0f / 128.0f) + EPS_);
                      const float g0v = __uint_as_float(graw[r][0] << 16), g1v = __uint_as_float(graw[r][0] & 0xffff0000u), g2v = __uint_as_float(graw[r][1] << 16), g3v = __uint_as_float(graw[r][1] & 0xffff0000u);
                      u32x2 pk = {cvt_pk_bf16(o[r][0] * rr * gn[0] * silu_f(g0v), o[r][1] * rr * gn[1] * silu_f(g1v)), cvt_pk_bf16(o[r][2] * rr * gn[2] * silu_f(g2v), o[r][3] * rr * gn[3] * silu_f(g3v))};
                      *(GAS u32x2*)((GAS bf16_t*)MIX + (size_t)(tk0 + i0 + r) * LD2 + h * 128 + e0) = pk;
                  } }
            }
            __syncthreads();
        }
#endif
    }
    xcd_barrier(xbar);
    {
        PHASE_IDS
        pg8::Gemm g{MIX, WOUT, S_, 2048, 2048, LD2, LD2}; pg8::StaticOrder so; so.init(g.M, g.N, nblk, blk);
        EpiResid e{X1, X2, XB, SSQ2, 1.0f};
        pg8::gemm_phase(lds, g, so, e);
    }
    xcd_barrier(xbar);
    {
        PHASE_IDS
        pg8::Gemm g{XB, WFF, S_, 11264, 2048, LD2, LD2}; pg8::StaticOrder so; so.init(g.M, g.N, nblk, blk);
        EpiGateUp e{ACT, SSQ2};
        pg8::gemm_phase(lds, g, so, e);
    }
    xcd_barrier(xbar);
    {
        PHASE_IDS
        pg8::Gemm g{ACT, WD, S_, 2048, FF_, LDF, LDF}; pg8::StaticOrder so; so.init(g.M, g.N, nblk, blk);
        if (nblk == 256) { EpiFinal e{X2, p.out, SSQ3, (unsigned*)(wsp + OFF_PCNT), p.final_norm, 0.5f}; pg8::gemm_phase(lds, g, so, e); }
        else { EpiResid e{X2, X3, nullptr, SSQ3, 0.5f}; pg8::gemm_phase(lds, g, so, e); }
    }
    if (nblk != 256) {
    xcd_barrier(xbar);
    { PHASE_IDS
    for (int r = gwave; r < S_; r += nwaves) {
        const float rs = rstd_from(SSQ3, r); float* row = p.out + (size_t)r * D_;
        f32x4 vv[8], gg[8];
#pragma unroll
        for (int i = 0; i < 8; ++i) { const int c = (lane + 64 * i) * 4; vv[i] = *(const GAS f32x4*)((const GAS float*)row + c); gg[i] = *(const GAS f32x4*)((const GAS float*)p.final_norm + c); }
#pragma unroll
        for (int i = 0; i < 8; ++i) { const int c = (lane + 64 * i) * 4; *(GAS f32x4*)((GAS float*)row + c) = vv[i] * rs * gg[i]; }
    }
    }
    }
}

extern "C" void kernel_launch(void* const* d_in, const int* in_sizes, int n_in, void* d_out, int out_size, void* d_ws, size_t ws_size, hipStream_t stream) {
    static int grid_blocks = 0;
    if (grid_blocks == 0) {
        if (n_in != 30 || ws_size < WS_END) { fprintf(stderr, "kernel_launch: need 30 inputs and %zu bytes of workspace (got %d, %zu)\n", (size_t)WS_END, n_in, ws_size); grid_blocks = -1; return; }
        int dev = 0, cus = 0, per_cu = 0;
        hipGetDevice(&dev); hipDeviceGetAttribute(&cus, hipDeviceAttributeMultiprocessorCount, dev);
        if (hipFuncSetAttribute((const void*)mega, hipFuncAttributeMaxDynamicSharedMemorySize, LDS_BYTES) != hipSuccess) { fprintf(stderr, "hipFuncSetAttribute failed\n"); grid_blocks = -1; return; }
        if (hipOccupancyMaxActiveBlocksPerMultiprocessor(&per_cu, (const void*)mega, 512, LDS_BYTES) != hipSuccess || per_cu < 1) per_cu = 1;
        (void)hipGetLastError();
        grid_blocks = cus * per_cu;
    }
    if (grid_blocks < 0) return;
    Params p{};
    const float** fp = (const float**)&p;
    (void)fp;
    p.x = (const float*)d_in[0]; p.mem = (const float*)d_in[1]; p.pos = (const int*)d_in[2];
    p.ffn1_norm = (const float*)d_in[3]; p.ffn1_wg = (const float*)d_in[4]; p.ffn1_wu = (const float*)d_in[5]; p.ffn1_wd = (const float*)d_in[6];
    p.mix_norm = (const float*)d_in[7]; p.w_in = (const float*)d_in[8]; p.gla_wa = (const float*)d_in[9]; p.gla_ba = (const float*)d_in[10]; p.gla_onorm = (const float*)d_in[11];
    p.q_norm = (const float*)d_in[12]; p.k_norm = (const float*)d_in[13]; p.cmp_pos_k = (const float*)d_in[14]; p.cmp_w1_k = (const float*)d_in[15]; p.cmp_w2_k = (const float*)d_in[16];
    p.cmp_pos_v = (const float*)d_in[17]; p.cmp_w1_v = (const float*)d_in[18]; p.cmp_w2_v = (const float*)d_in[19]; p.mem_in_norm = (const float*)d_in[20]; p.w_mem_kv = (const float*)d_in[21];
    p.mem_q_norm = (const float*)d_in[22]; p.mem_k_norm = (const float*)d_in[23]; p.w_out = (const float*)d_in[24]; p.ffn2_norm = (const float*)d_in[25]; p.ffn2_wg = (const float*)d_in[26];
    p.ffn2_wu = (const float*)d_in[27]; p.ffn2_wd = (const float*)d_in[28]; p.final_norm = (const float*)d_in[29];
    p.out = (float*)d_out; p.ws = (unsigned char*)d_ws;
    if (hipMemsetAsync((unsigned char*)d_ws + OFF_BAR, 0, BAR_BYTES, stream) != hipSuccess) { fprintf(stderr, "memset of barrier words failed\n"); return; }
    void* args[] = {&p};
    hipError_t e = hipLaunchCooperativeKernel((const void*)mega, dim3(grid_blocks), dim3(512), args, LDS_BYTES, stream);
    if (e != hipSuccess) fprintf(stderr, "cooperative launch failed: %s (grid %d)\n", hipGetErrorString(e), grid_blocks);
}
```
